# Optimizing an MI355X kernel written in HIP

```python
import jax
import jax.numpy as jnp
from jax import lax
import numpy as np

D_MODEL = 1024
BATCH = 8
SEQ = 4096
DEPTH = 1

CHUNK = 64
D_MLSTM = D_MODEL // 2
D_POOL = D_MODEL - D_MLSTM
N_HEADS = 4
HEAD_DIM = D_MLSTM // N_HEADS
CONV_WIDTH = 4
POOL_WINDOWS = (2, 4, 8, 16)
N_POOL_GROUPS = len(POOL_WINDOWS)
POOL_GROUP_DIM = D_POOL // N_POOL_GROUPS
N_EXPERT_GROUPS = 4
EXPERTS_PER_GROUP = 8
N_EXPERTS = N_EXPERT_GROUPS * EXPERTS_PER_GROUP
TOP_K = 2
D_EXPERT = D_MODEL // 2
MOE_BLOCK = 128
EPS = 1e-6

COL_U = 0
COL_V = COL_U + D_MLSTM
COL_O = COL_V + D_MLSTM
COL_I = COL_O + D_MLSTM
COL_F = COL_I + N_HEADS
COL_P = COL_F + N_HEADS
IN_COLS = COL_P + D_POOL

kernel_name = "hybrid_mlstm_pool_hmoe_block"


def rms_norm(x, g):
    xf = x.astype(jnp.float32)
    y = xf * lax.rsqrt(jnp.mean(xf * xf, axis=-1, keepdims=True) + EPS)
    return (y * g.astype(jnp.float32)).astype(x.dtype)


def causal_conv(x, w, b):
    k_w, ch = w.shape
    y = lax.conv_general_dilated(x, w[:, None, :], window_strides=(1,), padding=[(k_w - 1, 0)],
                                 dimension_numbers=('NWC', 'WIO', 'NWC'), feature_group_count=ch)
    return y + b


def mlstm_chunkwise(q, k, v, i_pre, f_pre):
    bsz, nh, seq, dh = q.shape
    nc = seq // CHUNK
    q = q.astype(jnp.float32) * (dh ** -0.5)
    k = k.astype(jnp.float32)
    v = v.astype(jnp.float32)
    log_i = i_pre.astype(jnp.float32)
    log_f = jax.nn.log_sigmoid(f_pre.astype(jnp.float32))

    def to_chunks(a):
        return jnp.moveaxis(a.reshape(bsz, nh, nc, CHUNK, *a.shape[3:]), 2, 0)

    qc, kc, vc, ic = to_chunks(q), to_chunks(k), to_chunks(v), to_chunks(log_i)
    bc = jnp.cumsum(to_chunks(log_f), axis=-1)
    causal = jnp.tril(jnp.ones((CHUNK, CHUNK), dtype=bool))

    def step(carry, inp):
        c_st, n_st, m_st = carry
        q_, k_, v_, ig, b_ = inp
        d_log = b_[..., :, None] - b_[..., None, :] + ig[..., None, :]
        d_log = jnp.where(causal, d_log, -jnp.inf)
        inter = b_ + m_st[..., None]
        m_t = jnp.maximum(inter, jnp.max(d_log, axis=-1))
        w_intra = jnp.exp(d_log - m_t[..., None])
        a_inter = jnp.exp(inter - m_t)
        s = jnp.einsum('bhtd,bhsd->bhts', q_, k_) * w_intra
        num = (a_inter[..., None] * jnp.einsum('bhed,bhtd->bhte', c_st, q_)
               + jnp.einsum('bhts,bhse->bhte', s, v_))
        den = a_inter * jnp.einsum('bhd,bhtd->bht', n_st, q_) + jnp.sum(s, axis=-1)
        h = num / jnp.maximum(jnp.abs(den), jnp.exp(-m_t))[..., None]
        b_last = b_[..., -1]
        w_log = b_last[..., None] - b_ + ig
        m_new = jnp.maximum(b_last + m_st, jnp.max(w_log, axis=-1))
        a_prev = jnp.exp(b_last + m_st - m_new)
        w_s = jnp.exp(w_log - m_new[..., None])
        c_new = a_prev[..., None, None] * c_st + jnp.einsum('bhs,bhse,bhsd->bhed', w_s, v_, k_)
        n_new = a_prev[..., None] * n_st + jnp.einsum('bhs,bhsd->bhd', w_s, k_)
        return (c_new, n_new, m_new), h

    init = (jnp.zeros((bsz, nh, dh, dh), jnp.float32), jnp.zeros((bsz, nh, dh), jnp.float32),
            jnp.zeros((bsz, nh), jnp.float32))
    _, hs = lax.scan(step, init, (qc, kc, vc, ic, bc))
    return jnp.moveaxis(hs, 0, 2).reshape(bsz, nh, seq, dh)


def mlstm_group(u, v, o_pre, i_pre, f_pre, conv_w, conv_b, w_q, w_k, b_i, b_f, norm_g, skip):
    bsz, seq, _ = u.shape
    uc = jax.nn.silu(causal_conv(u, conv_w, conv_b))
    uh = uc.reshape(bsz, seq, N_HEADS, HEAD_DIM)
    q = jnp.einsum('bshd,hde->bhse', uh, w_q)
    k = jnp.einsum('bshd,hde->bhse', uh, w_k)
    vh = v.reshape(bsz, seq, N_HEADS, HEAD_DIM).transpose(0, 2, 1, 3)
    ig = (i_pre + b_i).transpose(0, 2, 1)
    fg = (f_pre + b_f).transpose(0, 2, 1)
    h = mlstm_chunkwise(q, k, vh, ig, fg)
    h = h * lax.rsqrt(jnp.mean(h * h, axis=-1, keepdims=True) + EPS)
    h = h * norm_g.astype(jnp.float32).reshape(N_HEADS, 1, HEAD_DIM)
    h = h.transpose(0, 2, 1, 3).reshape(bsz, seq, D_MLSTM)
    out = jax.nn.sigmoid(o_pre.astype(jnp.float32)) * (h + skip.astype(jnp.float32) * uc.astype(jnp.float32))
    return out.astype(u.dtype)


def pool_group(p, w_pool, b_pool, pool_scale):
    bsz, seq, _ = p.shape
    pf = p.astype(jnp.float32).reshape(bsz, seq, N_POOL_GROUPS, POOL_GROUP_DIM)
    cs = jnp.pad(jnp.cumsum(pf, axis=1), ((0, 0), (1, 0), (0, 0), (0, 0)))
    t = jnp.arange(seq, dtype=jnp.int32)
    win = jnp.array(POOL_WINDOWS, dtype=jnp.int32)
    start = jnp.maximum(t[:, None] + 1 - win[None, :], 0)
    lo = cs[:, start, jnp.arange(N_POOL_GROUPS)[None, :]]
    count = jnp.minimum(t[:, None] + 1, win[None, :]).astype(jnp.float32)
    pooled = (cs[:, 1:] - lo) / count[None, :, :, None] - pf
    y = jnp.einsum('bsgc,gcd->bsgd', pooled, w_pool.astype(jnp.float32)).reshape(bsz, seq, D_POOL)
    y = (y + b_pool.astype(jnp.float32)) * pool_scale.astype(jnp.float32)
    return y.astype(p.dtype)


def hierarchical_moe(h, w_rg, b_rg, w_re, b_re, w_gate, w_up, w_down):
    bsz, seq, dm = h.shape
    n_tok = bsz * seq
    hf = h.reshape(n_tok, dm)
    g_logits = (hf @ w_rg + b_rg).astype(jnp.float32)
    g_prob = jax.nn.softmax(g_logits, axis=-1)
    g_idx = jnp.argmax(g_logits, axis=-1).astype(jnp.int32)
    g_gate = jnp.take_along_axis(g_prob, g_idx[:, None], axis=1)[:, 0]
    e_logits = (hf @ w_re + b_re).astype(jnp.float32).reshape(n_tok, N_EXPERT_GROUPS, EXPERTS_PER_GROUP)
    e_logits = jnp.take_along_axis(e_logits, g_idx[:, None, None], axis=1)[:, 0]
    top_val, top_loc = lax.top_k(e_logits, TOP_K)
    gates = jax.nn.softmax(top_val, axis=-1) * g_gate[:, None]
    expert = g_idx[:, None] * EXPERTS_PER_GROUP + top_loc.astype(jnp.int32)
    n_asg = n_tok * TOP_K
    flat_e = expert.reshape(n_asg)
    flat_tok = jnp.repeat(jnp.arange(n_tok, dtype=jnp.int32), TOP_K)
    flat_gate = gates.reshape(n_asg)
    order = jnp.argsort(flat_e)
    sorted_e = flat_e[order]
    counts = jnp.bincount(flat_e, length=N_EXPERTS).astype(jnp.int32)
    starts = jnp.cumsum(counts) - counts
    padded = (counts + MOE_BLOCK - 1) // MOE_BLOCK * MOE_BLOCK
    pad_ends = jnp.cumsum(padded)
    pad_starts = pad_ends - padded
    rank = jnp.arange(n_asg, dtype=jnp.int32) - starts[sorted_e]
    dest = pad_starts[sorted_e] + rank
    n_blocks = (n_asg + MOE_BLOCK - 1) // MOE_BLOCK + N_EXPERTS
    n_slots = n_blocks * MOE_BLOCK
    slot_tok = jnp.full((n_slots,), n_tok, jnp.int32).at[dest].set(flat_tok[order])
    slot_gate = jnp.zeros((n_slots,), jnp.float32).at[dest].set(flat_gate[order])
    block_pos = jnp.arange(n_blocks, dtype=jnp.int32) * MOE_BLOCK
    block_expert = jnp.minimum(jnp.searchsorted(pad_ends, block_pos, side='right'), N_EXPERTS - 1)

    def run_block(args):
        tok, e = args
        xb = hf[jnp.minimum(tok, n_tok - 1)]
        a = xb @ w_gate[e]
        b = xb @ w_up[e]
        return (jax.nn.silu(a) * b) @ w_down[e]

    out = lax.map(run_block, (slot_tok.reshape(n_blocks, MOE_BLOCK), block_expert))
    out = (out.reshape(n_slots, dm).astype(jnp.float32) * slot_gate[:, None]).astype(h.dtype)
    y = jnp.zeros((n_tok, dm), h.dtype).at[slot_tok].add(out, mode='drop')
    return y.reshape(bsz, seq, dm)


def setup_inputs(seed: int = 0) -> dict:
    key = jax.random.key(seed)
    ks = jax.random.split(key, 28)
    L = DEPTH

    def nrm(k, shape, scale):
        return jax.random.normal(k, shape, jnp.float32) * scale

    return {
        'x': nrm(ks[0], (BATCH, SEQ, D_MODEL), 1.0),
        'c': nrm(ks[1], (BATCH, D_MODEL), 1.0),
        'ada_w': nrm(ks[2], (L, D_MODEL, 6 * D_MODEL), D_MODEL ** -0.5),
        'ada_b': nrm(ks[3], (L, 6 * D_MODEL), 0.02),
        'norm1_g': 1.0 + nrm(ks[4], (L, D_MODEL), 0.02),
        'w_in': nrm(ks[5], (L, D_MODEL, IN_COLS), D_MODEL ** -0.5),
        'conv_w': nrm(ks[6], (L, CONV_WIDTH, D_MLSTM), CONV_WIDTH ** -0.5),
        'conv_b': nrm(ks[7], (L, D_MLSTM), 0.02),
        'w_q': nrm(ks[8], (L, N_HEADS, HEAD_DIM, HEAD_DIM), HEAD_DIM ** -0.5),
        'w_k': nrm(ks[9], (L, N_HEADS, HEAD_DIM, HEAD_DIM), HEAD_DIM ** -0.5),
        'b_igate': nrm(ks[10], (L, N_HEADS), 0.1),
        'b_fgate': jnp.linspace(3.0, 6.0, N_HEADS, dtype=jnp.float32)[None, :] + nrm(ks[11], (L, N_HEADS), 0.1),
        'mlstm_norm_g': 1.0 + nrm(ks[12], (L, D_MLSTM), 0.02),
        'mlstm_skip': 1.0 + nrm(ks[13], (L, D_MLSTM), 0.1),
        'w_pool': nrm(ks[14], (L, N_POOL_GROUPS, POOL_GROUP_DIM, POOL_GROUP_DIM), POOL_GROUP_DIM ** -0.5),
        'b_pool': nrm(ks[15], (L, D_POOL), 0.02),
        'pool_scale': 1.0 + nrm(ks[16], (L, D_POOL), 0.1),
        'w_out': nrm(ks[17], (L, D_MODEL, D_MODEL), D_MODEL ** -0.5),
        'norm2_g': 1.0 + nrm(ks[18], (L, D_MODEL), 0.02),
        'w_router_group': nrm(ks[19], (L, D_MODEL, N_EXPERT_GROUPS), D_MODEL ** -0.5),
        'b_router_group': nrm(ks[20], (L, N_EXPERT_GROUPS), 0.01),
        'w_router_expert': nrm(ks[21], (L, D_MODEL, N_EXPERTS), D_MODEL ** -0.5),
        'b_router_expert': nrm(ks[22], (L, N_EXPERTS), 0.01),
        'w_expert_gate': nrm(ks[23], (L, N_EXPERTS, D_MODEL, D_EXPERT), D_MODEL ** -0.5),
        'w_expert_up': nrm(ks[24], (L, N_EXPERTS, D_MODEL, D_EXPERT), D_MODEL ** -0.5),
        'w_expert_down': nrm(ks[25], (L, N_EXPERTS, D_EXPERT, D_MODEL), D_EXPERT ** -0.5),
        'final_g': 1.0 + nrm(ks[26], (D_MODEL,), 0.02),
    }


def reference(x, c, ada_w, ada_b, norm1_g, w_in, conv_w, conv_b, w_q, w_k, b_igate, b_fgate,
              mlstm_norm_g, mlstm_skip, w_pool, b_pool, pool_scale, w_out, norm2_g,
              w_router_group, b_router_group, w_router_expert, b_router_expert,
              w_expert_gate, w_expert_up, w_expert_down, final_g):
    bsz, seq, dm = x.shape
    for l in range(DEPTH):
        mod = (jax.nn.silu(c) @ ada_w[l] + ada_b[l]).reshape(bsz, 6, dm)
        shift_a, scale_a, gate_a = mod[:, 0, None, :], mod[:, 1, None, :], mod[:, 2, None, :]
        shift_f, scale_f, gate_f = mod[:, 3, None, :], mod[:, 4, None, :], mod[:, 5, None, :]
        h = rms_norm(x, norm1_g[l]) * (1.0 + scale_a) + shift_a
        proj = h @ w_in[l]
        y_m = mlstm_group(proj[..., COL_U:COL_V], proj[..., COL_V:COL_O], proj[..., COL_O:COL_I],
                          proj[..., COL_I:COL_F], proj[..., COL_F:COL_P], conv_w[l], conv_b[l],
                          w_q[l], w_k[l], b_igate[l], b_fgate[l], mlstm_norm_g[l], mlstm_skip[l])
        y_p = pool_group(proj[..., COL_P:IN_COLS], w_pool[l], b_pool[l], pool_scale[l])
        mix = jnp.concatenate([y_m, y_p], axis=-1) @ w_out[l]
        x = x + gate_a * mix
        h = rms_norm(x, norm2_g[l]) * (1.0 + scale_f) + shift_f
        x = x + gate_f * hierarchical_moe(h, w_router_group[l], b_router_group[l], w_router_expert[l],
                                          b_router_expert[l], w_expert_gate[l], w_expert_up[l],
                                          w_expert_down[l])
    return rms_norm(x, final_g)
```

```cpp
#define HYB 0
#include <hip/hip_runtime.h>
#include <stdint.h>
#include <stdio.h>
namespace pg8 {
#define PG8_LAS __attribute__((address_space(3)))
typedef unsigned short bf16_t;
typedef short bf16x8 __attribute__((ext_vector_type(8)));
typedef float f32x4 __attribute__((ext_vector_type(4)));
typedef unsigned u32x4 __attribute__((ext_vector_type(4)));
constexpr int BM = 256, BK = 64, HALF = 128, HTB = HALF * BK * 2  , STAGE_BYTES = 8 * HTB, NXCD = 8, WGM = 8;

__host__ __device__ __forceinline__ int lds_byte(int r, int c) { const int st = (r >> 4) * 2 + (c >> 5), rr = r & 15, cc = c & 31, ob = rr * 64 + cc * 2; return st * 1024 + (ob ^ (((ob >> 9) & 1) << 5)); }
__host__ __device__ __forceinline__ void stage_rc(int b, int& R, int& C) { const int st = b / 1024, sb = b % 1024, swz = sb ^ (((sb >> 9) & 1) << 5); R = (st >> 1) * 16 + swz / 64; C = (st & 1) * 32 + (swz % 64) / 2; }
__host__ __device__ __forceinline__ int perm32(int rho) { const int n = rho >> 4, i = rho & 15; return 8 * (i >> 2) + 4 * n + (i & 3); }

struct Unit { const char* A; const char* B; int pm, pn, e, nvalid; };

typedef __bf16 bf16x2_t __attribute__((ext_vector_type(2)));
__device__ __forceinline__ unsigned cvt_pk_bf16(float lo, float hi) { bf16x2_t v; v[0] = (__bf16)lo; v[1] = (__bf16)hi; return __builtin_bit_cast(unsigned, v); }

struct DenseOrder {
    const char* A; const char* Bt; int K; int nM, nN, nwg, G, c;
    __device__ void init(const void* A_, const void* Bt_, int M, int N, int K_, int G_, int c_) { A = (const char*)A_; Bt = (const char*)Bt_; K = K_; nM = M / BM; nN = N / BM; nwg = nM * nN; G = G_; c = c_; }
    __device__ __forceinline__ bool next(int i, Unit& u) const {
        const long L = (long)i * G + c; if (L >= nwg) return false;
        int wgid = (int)L; { const int q = nwg / NXCD, r = nwg % NXCD, xcd = wgid % NXCD, off = wgid / NXCD; wgid = (xcd < r ? xcd * (q + 1) : r * (q + 1) + (xcd - r) * q) + off; }
        const int nig = WGM * nN, gid = wgid / nig, fm = gid * WGM, gsz = (nM - fm) < WGM ? (nM - fm) : WGM;
        u.pm = fm + ((wgid % nig) % gsz); u.pn = (wgid % nig) / gsz; u.e = 0; u.nvalid = 256;
        u.A = A + (size_t)u.pm * BM * K * 2; u.B = Bt + (size_t)u.pn * BM * K * 2; return true;
    }
    __device__ __forceinline__ unsigned a_row_off(const Unit&, int r) const { return (unsigned)(r * K * 2); }
    __device__ __forceinline__ void a_ready(const Unit&) const {}
    __device__ __forceinline__ void done(const Unit&) const {}
};

template <class Epi, class Sched, bool ALIGN_EPI>
__device__ __forceinline__ void gemm_phase(PG8_LAS unsigned char* lds, const int K, const Sched& S, const Epi& E) {
    const int tid = threadIdx.x, wid = __builtin_amdgcn_readfirstlane(tid >> 6), lane = tid & 63, wr = wid >> 2, wc = wid & 3, fr = lane & 15, fq = lane >> 4;
    const int nt = K / BK;
    int Rr[2], Cc2[2]; unsigned voffB[2];
#pragma unroll
    for (int i = 0; i < 2; ++i) { int R, C; stage_rc(tid * 16 + i * 8192, R, C); const int Rb = Epi::PERM ? ((R & ~31) + perm32(R & 31)) : R;
        Rr[i] = R; Cc2[i] = C * 2; voffB[i] = (unsigned)(Rb * K + C) * 2u; }
    const size_t kstep = (size_t)(BK * 2);
    const size_t hstep = (size_t)HALF * K * 2;
    const unsigned ldsw = (unsigned)wid * 1024u;
    const int aoff = lds_byte(wr * 64 + fr, fq * 8), boff = lds_byte(wc * 32 + fr, fq * 8);
#define PG8_SA(b, h) (((b) * 2 + (h)) * HTB)
#define PG8_SB(b, h) ((4 + (b) * 2 + (h)) * HTB)
#define PG8_STAGE(bufoff, gbase, voff) do { _Pragma("unroll") for (int _i = 0; _i < 2; ++_i) \
        __builtin_amdgcn_global_load_lds((const unsigned*)((const char*)(gbase) + (voff)[_i]), (PG8_LAS unsigned*)(lds + (bufoff) + ldsw + _i * 8192), 16, 0, 0); } while (0)
#define PG8_LDA(dst, b, h) do { _Pragma("unroll") for (int m = 0; m < 4; ++m) _Pragma("unroll") for (int k = 0; k < 2; ++k) dst[m][k] = *(const PG8_LAS bf16x8*)(lds + PG8_SA(b, h) + aoff + m * 2048 + k * 1024); } while (0)
#define PG8_LDB(dst, b, h) do { _Pragma("unroll") for (int n = 0; n < 2; ++n) _Pragma("unroll") for (int k = 0; k < 2; ++k) dst[n][k] = *(const PG8_LAS bf16x8*)(lds + PG8_SB(b, h) + boff + n * 2048 + k * 1024); } while (0)
#define PG8_MMA(ai, bj, At, Bt) do { __builtin_amdgcn_s_setprio(1); _Pragma("unroll") for (int m = 0; m < 4; ++m) _Pragma("unroll") for (int n = 0; n < 2; ++n) _Pragma("unroll") for (int k = 0; k < 2; ++k) \
        acc[ai][bj][m][n] = __builtin_amdgcn_mfma_f32_16x16x32_bf16(Bt[n][k], At[m][k], acc[ai][bj][m][n], 0, 0, 0); __builtin_amdgcn_s_setprio(0); } while (0)
#define PG8_WAIT_V(n) asm volatile("s_waitcnt vmcnt(" #n ")" ::: "memory")
#define PG8_WAIT_L(n) asm volatile("s_waitcnt lgkmcnt(" #n ")" ::: "memory")
#define PG8_BAR __builtin_amdgcn_s_barrier()
#define PG8_SCHED __builtin_amdgcn_sched_barrier(0)
#define PG8_LOADVA(dst, u) do { _Pragma("unroll") for (int _h = 0; _h < 2; ++_h) _Pragma("unroll") for (int _i = 0; _i < 2; ++_i) dst[_h][_i] = S.a_row_off(u, _h * HALF + Rr[_i]) + (unsigned)Cc2[_i]; } while (0)
    Unit cur, nxt; int ui = 0;
    if (!S.next(0, cur)) return;
    f32x4 acc[2][2][4][2];
#pragma unroll
    for (int a = 0; a < 2; ++a)
#pragma unroll
        for (int b = 0; b < 2; ++b)
#pragma unroll
            for (int m = 0; m < 4; ++m)
#pragma unroll
                for (int n = 0; n < 2; ++n) acc[a][b][m][n] = (f32x4){0.f, 0.f, 0.f, 0.f};
    bf16x8 At[4][2], B0[2][2], B1[2][2];
    unsigned vA[2][2], vN[2][2];
    const char* cA = cur.A; const char* cB = cur.B;
    S.a_ready(cur);
    PG8_LOADVA(vA, cur);
    PG8_STAGE(PG8_SB(0, 0), cB, voffB); PG8_STAGE(PG8_SB(0, 1), cB + hstep, voffB); PG8_STAGE(PG8_SA(0, 0), cA, vA[0]); PG8_STAGE(PG8_SA(0, 1), cA, vA[1]);
    if (wr == 1) PG8_BAR;
    PG8_WAIT_V(2); PG8_BAR;
    PG8_STAGE(PG8_SB(1, 0), cB + kstep, voffB); PG8_STAGE(PG8_SA(1, 0), cA + kstep, vA[0]); PG8_STAGE(PG8_SB(1, 1), cB + hstep + kstep, voffB);
    PG8_WAIT_V(6); PG8_BAR;
    for (;;) {
        const bool has_next = S.next(ui + 1, nxt);
        const char* nA = has_next ? nxt.A : cA; const char* nB = has_next ? nxt.B : cB;
        for (int t = 0; t < nt; t += 2) {
            const bool last = (t == nt - 2);
            if (last) { if (has_next) { S.a_ready(nxt); PG8_LOADVA(vN, nxt); } else {
#pragma unroll
                for (int _h = 0; _h < 2; ++_h)
#pragma unroll
                    for (int _i = 0; _i < 2; ++_i) vN[_h][_i] = vA[_h][_i]; } }
            const char* a1 = cA + (size_t)(t + 1) * kstep;
            const char* a2 = last ? nA : cA + (size_t)(t + 2) * kstep; const char* b2 = last ? nB : cB + (size_t)(t + 2) * kstep;
            const char* a3 = a2 + kstep; const char* b3 = b2 + kstep;
            unsigned o0[2], o1[2];
#pragma unroll
            for (int _i = 0; _i < 2; ++_i) { o0[_i] = last ? vN[0][_i] : vA[0][_i]; o1[_i] = last ? vN[1][_i] : vA[1][_i]; }
            PG8_LDB(B0, 0, 0); PG8_LDB(B1, 0, 1); PG8_SCHED; PG8_LDA(At, 0, 0); PG8_STAGE(PG8_SA(1, 1), a1, vA[1]);
            PG8_WAIT_V(8); PG8_WAIT_L(0); PG8_BAR; PG8_MMA(0, 0, At, B0); PG8_MMA(0, 1, At, B1); PG8_BAR; PG8_SCHED;
            PG8_LDA(At, 0, 1); PG8_STAGE(PG8_SB(0, 0), b2, voffB); PG8_STAGE(PG8_SB(0, 1), b2 + hstep, voffB); PG8_STAGE(PG8_SA(0, 0), a2, o0);
            PG8_WAIT_V(8); PG8_WAIT_L(0); PG8_BAR; PG8_MMA(1, 0, At, B0); PG8_MMA(1, 1, At, B1); PG8_BAR; PG8_SCHED;
            PG8_LDB(B0, 1, 0); PG8_LDB(B1, 1, 1); PG8_SCHED; PG8_LDA(At, 1, 0); PG8_STAGE(PG8_SA(0, 1), a2, o1);
            PG8_WAIT_V(8); PG8_WAIT_L(0); PG8_BAR; PG8_MMA(0, 0, At, B0); PG8_MMA(0, 1, At, B1); PG8_BAR; PG8_SCHED;
            PG8_LDA(At, 1, 1); PG8_STAGE(PG8_SB(1, 0), b3, voffB); PG8_STAGE(PG8_SB(1, 1), b3 + hstep, voffB); PG8_STAGE(PG8_SA(1, 0), a3, o0);
            PG8_WAIT_V(8); PG8_WAIT_L(0); PG8_BAR; PG8_MMA(1, 0, At, B0); PG8_MMA(1, 1, At, B1); PG8_BAR; PG8_SCHED;
        }
        if constexpr (ALIGN_EPI) { if (wr == 0) PG8_BAR; }
        E(acc, cur, wr, wc, fr, fq); S.done(cur);
        if (!has_next) break;
#pragma unroll
        for (int a = 0; a < 2; ++a)
#pragma unroll
            for (int b = 0; b < 2; ++b)
#pragma unroll
                for (int m = 0; m < 4; ++m)
#pragma unroll
                    for (int n = 0; n < 2; ++n) acc[a][b][m][n] = (f32x4){0.f, 0.f, 0.f, 0.f};
        cur = nxt; cA = nA; cB = nB; ++ui;
#pragma unroll
        for (int _h = 0; _h < 2; ++_h)
#pragma unroll
            for (int _i = 0; _i < 2; ++_i) vA[_h][_i] = vN[_h][_i];
        if constexpr (ALIGN_EPI) { if (wr == 1) PG8_BAR; }
    }
    PG8_WAIT_V(0);
    if constexpr (!ALIGN_EPI) { if (wr == 0) PG8_BAR; }
    PG8_BAR;
#undef PG8_SA
#undef PG8_SB
#undef PG8_STAGE
#undef PG8_LDA
#undef PG8_LDB
#undef PG8_MMA
#undef PG8_WAIT_V
#undef PG8_WAIT_L
#undef PG8_BAR
#undef PG8_SCHED
#undef PG8_LOADVA
}
}

constexpr int T_TOK = 32768, D_M = 1024, N_PROJ = 2048, NWAVES = 8;
constexpr size_t MiB = 1u << 20;
constexpr size_t WS_CTL = 0, CTL_ZERO_BYTES = 1 * MiB;
constexpr size_t WS_MOD = 1 * MiB;
constexpr size_t WS_GIF = 2 * MiB;
constexpr size_t WS_ASGE = 3 * MiB;
constexpr size_t WS_ASGG = 3 * MiB + 256 * 1024;
constexpr size_t WS_LIST = 4 * MiB;
constexpr size_t WS_WIN = 8 * MiB;
constexpr size_t WS_WQ = 12 * MiB, WS_WK = WS_WQ + 128 * 1024, WS_WPOOL = WS_WK + 128 * 1024;
constexpr size_t WS_WOUT = 12 * MiB + 512 * 1024;
constexpr size_t WS_WR = 14 * MiB + 512 * 1024;
constexpr size_t WS_WGU = 16 * MiB;
constexpr size_t WS_WD = 80 * MiB;
#if defined(HYB) && HYB == 1
constexpr size_t WS_ACT1 = 16 * MiB, WS_PROJ = 80 * MiB;
#define CVT_LIMIT 216
#elif defined(HYB) && HYB == 2
constexpr size_t WS_ACT1 = 112 * MiB, WS_PROJ = 0;
#define CVT_LIMIT CVT_NTILES
#define PROJ_IN_OUT 1
#else
constexpr size_t WS_ACT1 = 112 * MiB;
constexpr size_t WS_PROJ = 176 * MiB;
#define CVT_LIMIT CVT_NTILES
#endif
constexpr size_t WS_HID = 176 * MiB;
constexpr size_t WS_SLOT = 248 * MiB;
constexpr int CAPX = 32768;
constexpr int CW_TMO = 0;
constexpr int CW_BAR = 4096;
constexpr int CW_CNT = 16384;

constexpr int RING_BYTES = 131072;
constexpr int MISC_OFF = RING_BYTES;
constexpr int MOE_OFF = RING_BYTES + 256;
constexpr int LDS_BYTES = 147456;

#define GAS __attribute__((address_space(1)))
#define LAS __attribute__((address_space(3)))
typedef unsigned short bf16;
typedef float f32x4 __attribute__((ext_vector_type(4)));
typedef unsigned u32x4 __attribute__((ext_vector_type(4)));
typedef GAS unsigned gu32;
#define RLX_AGENT __ATOMIC_RELAXED, __HIP_MEMORY_SCOPE_AGENT
#define VM_WAIT() asm volatile("s_waitcnt vmcnt(0)" ::: "memory")

#define XB_TMO      128
#define XB_XCNT(j)  (256  + 64 * (j))
#define XB_XSUB(j)  (1280 + 64 * (j))
#define XB_XGEN(j)  (2304 + 64 * (j))
#define XB_TOP      3328
#define XB_TOPGEN   3392
#define XCD_BAR_WORDS 3456
#define XB_SPIN_CAP (1u << 18)
__device__ __forceinline__ unsigned xb_ld(unsigned* p)              { return __hip_atomic_load(p, __ATOMIC_RELAXED, __HIP_MEMORY_SCOPE_AGENT); }
__device__ __forceinline__ unsigned xb_add(unsigned* p, unsigned v) { return __hip_atomic_fetch_add(p, v, __ATOMIC_RELAXED, __HIP_MEMORY_SCOPE_AGENT); }
__device__ __forceinline__ unsigned xb_xcc_id() { return (unsigned)__builtin_amdgcn_s_getreg((3 << 11) | 20) & 0xFu; }
#define XB_SPIN(cond, bar) do { unsigned _sp = 0; while (cond) { __builtin_amdgcn_s_sleep(1); \
    if ((++_sp & 255u) == 0u) { if (xb_ld(&(bar)[XB_TMO])) break; if (_sp > XB_SPIN_CAP) { atomicAdd(&(bar)[XB_TMO], 1u); break; } } } } while (0)
struct XcdBarrier { unsigned* bar; unsigned x; volatile LAS unsigned* st; };
__device__ __forceinline__ XcdBarrier xcd_barrier_post(unsigned* bar, volatile LAS unsigned* st) {
    XcdBarrier b; b.bar = bar; b.x = xb_xcc_id(); b.st = st;
    if (threadIdx.x == 0) (void)xb_add(&bar[XB_XCNT(b.x)], 1u);
    return b;
}
__device__ __forceinline__ void xcd_barrier_complete(unsigned* bar, unsigned x, unsigned& nloc, unsigned& nx) {
    const unsigned G = gridDim.x * gridDim.y * gridDim.z;
    unsigned sum, cnt, mine, sp = 0u;
    for (;;) {
        sum = 0u; cnt = 0u; mine = 0u;
#pragma unroll
        for (unsigned j = 0; j < 16; ++j) { const unsigned c = xb_ld(&bar[XB_XCNT(j)]); sum += c; cnt += (c > 0u) ? 1u : 0u; mine = (j == x) ? c : mine; }
        if (sum == G) break;
        __builtin_amdgcn_s_sleep(1);
        if ((++sp & 255u) == 0u) { if (xb_ld(&bar[XB_TMO])) break; if (sp > XB_SPIN_CAP) { atomicAdd(&bar[XB_TMO], 1u); break; } }
    }
    nloc = mine > 0u ? mine : 1u; nx = cnt > 0u ? cnt : 1u;
}
__device__ __forceinline__ void xcd_barrier(const XcdBarrier& b) {
    asm volatile("s_waitcnt vmcnt(0)" ::: "memory");
    __syncthreads();
    if (threadIdx.x == 0) {
        unsigned* bar = b.bar;
        __builtin_amdgcn_s_waitcnt(0);
        unsigned nloc = b.st[0], nx = b.st[1];
        if (nloc == 0u) { xcd_barrier_complete(bar, b.x, nloc, nx); b.st[0] = nloc; b.st[1] = nx; }
        const unsigned old = xb_add(&bar[XB_XSUB(b.x)], 1u);
        const unsigned gen = old / nloc;
        if (old + 1u == (gen + 1u) * nloc) {
            __builtin_amdgcn_fence(__ATOMIC_RELEASE, "agent");
            asm volatile("s_waitcnt vmcnt(0)" ::: "memory");
            const unsigned og = xb_add(&bar[XB_TOP], 1u);
            const unsigned tg = og / nx;
            if (og + 1u == (tg + 1u) * nx) xb_add(&bar[XB_TOPGEN], 1u);
            else XB_SPIN(xb_ld(&bar[XB_TOPGEN]) == tg, bar);
            __builtin_amdgcn_fence(__ATOMIC_ACQUIRE, "agent");
            xb_add(&bar[XB_XGEN(b.x)], 1u);
            asm volatile("s_waitcnt vmcnt(0)" ::: "memory");
        } else {
            XB_SPIN(xb_ld(&bar[XB_XGEN(b.x)]) == gen, bar);
            __builtin_amdgcn_fence(__ATOMIC_ACQUIRE, "agent");
            asm volatile("s_waitcnt vmcnt(0)" ::: "memory");
        }
    }
    __syncthreads();
}

struct Args { const float* in[27]; float* out; unsigned char* ws; int ph_lo, ph_hi; };
struct Frame {
    LAS unsigned char* lds; int tid, lane, wave, G;
    const float* const* in; float* out; unsigned char* ws; unsigned* ctl; bf16* proj;
};
__device__ __forceinline__ unsigned pk2(float lo, float hi) { return pg8::cvt_pk_bf16(lo, hi); }
__device__ __forceinline__ float bf2f(unsigned short v) { return __builtin_bit_cast(float, (unsigned)v << 16); }
__device__ __forceinline__ float wave_sum(float v) {
#pragma unroll
    for (int o = 32; o > 0; o >>= 1) v += __shfl_xor(v, o);
    return v;
}
__device__ __forceinline__ float silu_f(float a) { return a / (1.f + __expf(-a)); }

constexpr int CVT_NTILES = 128 + 24 + 64 + 1024 + 1024 + 1024;
__device__ __forceinline__ void p0_cvt_tile(const Frame& F, int id) {
    const float* src; int ld_src; bf16* dst; int ld_dst; int width = 256; int mode = 0; int n0 = 0; int add = 0; int k0;
    unsigned char* ws = F.ws;
    if (id < 128) {
        const int kt = id >> 3, nt = id & 7; k0 = kt * 64; n0 = nt * 256;
        const int sc = (nt < 6) ? n0 : n0 + 8;
        src = F.in[5] + (size_t)k0 * 2056 + sc; ld_src = 2056; dst = (bf16*)(ws + WS_WIN); ld_dst = 1024;
    } else if (id < 152) {
        const int j = id - 128, which = j >> 3, hh = (j >> 1) & 3, kt = j & 1; k0 = kt * 64; width = 128;
        src = (which == 0 ? F.in[8] : (which == 1 ? F.in[9] : F.in[14])) + (size_t)hh * 16384 + (size_t)k0 * 128; ld_src = 128;
        dst = (bf16*)(ws + (which == 0 ? WS_WQ : (which == 1 ? WS_WK : WS_WPOOL))) + (size_t)hh * 16384; ld_dst = 128;
    } else if (id < 216) {
        const int j = id - 152, kt = j >> 2, nt = j & 3; k0 = kt * 64; n0 = nt * 256;
        src = F.in[17] + (size_t)k0 * 1024 + n0; ld_src = 1024; dst = (bf16*)(ws + WS_WOUT); ld_dst = 1024;
    } else if (id < 216 + 2048) {
        int j = id - 216; const int up = j >= 1024; j &= 1023; const int e = j >> 5, kt = (j >> 1) & 15, nt = j & 1; k0 = kt * 64; n0 = nt * 256;
        src = (up ? F.in[24] : F.in[23]) + (size_t)e * 1024 * 512 + (size_t)k0 * 512 + n0; ld_src = 512;
        dst = (bf16*)(ws + WS_WGU) + (size_t)e * 1024 * 1024; ld_dst = 1024; mode = 1; add = up ? 128 : 0;
    } else {
        const int j = id - 216 - 2048, e = j >> 5, kt = (j >> 2) & 7, nt = j & 3; k0 = kt * 64; n0 = nt * 256;
        src = F.in[25] + (size_t)e * 512 * 1024 + (size_t)k0 * 1024 + n0; ld_src = 1024;
        dst = (bf16*)(ws + WS_WD) + (size_t)e * 1024 * 512; ld_dst = 512;
    }
    LAS float* tl = (LAS float*)F.lds;
    const int pitch = width + 1;
    const int f4_per_row = width >> 2;
    const int nload = (64 * f4_per_row) / 512;
    f32x4 v[8];
#pragma unroll
    for (int p = 0; p < 8; ++p) if (p < nload) { const int idx = F.tid + p * 512, row = idx / f4_per_row, c4 = idx % f4_per_row;
        v[p] = *(const f32x4*)(src + (size_t)row * ld_src + 4 * c4); }
#pragma unroll
    for (int p = 0; p < 8; ++p) if (p < nload) { const int idx = F.tid + p * 512, row = idx / f4_per_row, c4 = idx % f4_per_row;
        tl[row * pitch + 4 * c4 + 0] = v[p][0]; tl[row * pitch + 4 * c4 + 1] = v[p][1]; tl[row * pitch + 4 * c4 + 2] = v[p][2]; tl[row * pitch + 4 * c4 + 3] = v[p][3]; }
    __syncthreads();
    const int nitems = width * 8 / 512;
#pragma unroll
    for (int p = 0; p < 4; ++p) if (p < nitems) { const int idx = F.tid + p * 512, n = idx >> 3, ks = idx & 7;
        float a[8];
#pragma unroll
        for (int j = 0; j < 8; ++j) a[j] = tl[(8 * ks + j) * pitch + n];
        u32x4 w; w.x = pk2(a[0], a[1]); w.y = pk2(a[2], a[3]); w.z = pk2(a[4], a[5]); w.w = pk2(a[6], a[7]);
        const int ng = n0 + n;
        const int drow = (mode == 1) ? (256 * (ng >> 7) + (ng & 127) + add) : ng;
        *(u32x4*)(dst + (size_t)drow * ld_dst + k0 + 8 * ks) = w; }
    __syncthreads();
}

__device__ __forceinline__ void p0_mod(const Frame& F, int cg) {
    LAS float* sc = (LAS float*)F.lds;
    LAS float* red = (LAS float*)(F.lds + 32768);
    const float* c = F.in[1]; const float* ada_w = F.in[2]; const float* ada_b = F.in[3];
    float* mod = (float*)(F.ws + WS_MOD);
    for (int i = F.tid; i < 8192; i += 512) sc[i] = silu_f(c[i]);
    __syncthreads();
    const int g = F.tid % 6, kl = F.tid / 6;
    if (kl < 85) {
        f32x4 acc[8];
#pragma unroll
        for (int b = 0; b < 8; ++b) acc[b] = (f32x4){0.f, 0.f, 0.f, 0.f};
        for (int k = kl; k < 1024; k += 85) {
            const f32x4 w = *(const f32x4*)(ada_w + (size_t)k * 6144 + 24 * cg + 4 * g);
#pragma unroll
            for (int b = 0; b < 8; ++b) acc[b] += w * sc[b * 1024 + k];
        }
#pragma unroll
        for (int b = 0; b < 8; ++b)
#pragma unroll
            for (int j = 0; j < 4; ++j) red[(kl * 6 + g) * 32 + b * 4 + j] = acc[b][j];
    }
    __syncthreads();
    if (F.tid < 192) {
        const int gg = F.tid >> 5, bj = F.tid & 31, b = bj >> 2, j = bj & 3;
        float s = 0.f;
        for (int k = 0; k < 85; ++k) s += red[(k * 6 + gg) * 32 + bj];
        const int col = 24 * cg + 4 * gg + j;
        mod[b * 6144 + col] = s + ada_b[col];
    }
    __syncthreads();
}

__device__ __forceinline__ void p0_prologue(const Frame& F) {
    for (int id = blockIdx.x; id < CVT_LIMIT; id += F.G) p0_cvt_tile(F, id);
    for (int cg = blockIdx.x; cg < 256; cg += F.G) p0_mod(F, cg);
}

__device__ __forceinline__ void split_hi_lo(const float (&a)[8], u32x4& hi, u32x4& lo) {
    unsigned h[4], l[4];
#pragma unroll
    for (int j = 0; j < 4; ++j) { h[j] = pk2(a[2 * j], a[2 * j + 1]);
        const float r0 = a[2 * j] - __builtin_bit_cast(float, h[j] << 16), r1 = a[2 * j + 1] - __builtin_bit_cast(float, h[j] & 0xffff0000u);
        l[j] = pk2(r0, r1); }
    hi = (u32x4){h[0], h[1], h[2], h[3]}; lo = (u32x4){l[0], l[1], l[2], l[3]};
}
__device__ __forceinline__ void p1_router_weights(const Frame& F) {
    const float* g2 = F.in[18]; const float* w_rg = F.in[19]; const float* w_re = F.in[21]; const float* mod = (const float*)(F.ws + WS_MOD);
    u32x4* wr = (u32x4*)(F.ws + WS_WR);
    for (int item = blockIdx.x * 512 + F.tid; item < 8 * 8 * 3 * 4 * 64; item += F.G * 512) {
        const int lane = item & 63, s = (item >> 6) & 3, nt = (item >> 8) % 3, w = ((item >> 8) / 3) & 7, b = (item >> 8) / 24;
        const int tl = lane & 15, g = lane >> 4, c = 16 * nt + tl;
        float a[8];
#pragma unroll
        for (int j = 0; j < 8; ++j) { const int k = 128 * w + 32 * s + 8 * g + j;
            const float wv = (c < 4) ? w_rg[k * 4 + c] : (c < 36 ? w_re[k * 32 + (c - 4)] : 0.f);
            a[j] = g2[k] * (1.f + mod[b * 6144 + 4 * 1024 + k]) * wv; }
        u32x4 hi, lo; split_hi_lo(a, hi, lo);
        const size_t base = ((((size_t)b * 8 + w) * 3 + nt) * 4 + s) * 2;
        wr[(base + 0) * 64 + lane] = hi; wr[(base + 1) * 64 + lane] = lo;
    }
}
__device__ __forceinline__ void p1_norm1(const Frame& F) {
    p1_router_weights(F);
    const float* x = F.in[0]; const float* g1 = F.in[4]; const float* w_in = F.in[5];
    const float* mod = (const float*)(F.ws + WS_MOD);
    bf16* h = (bf16*)(F.ws + WS_ACT1); float* gif = (float*)(F.ws + WS_GIF);
    const int lane = F.lane;
    float wg[16][8];
#pragma unroll
    for (int i = 0; i < 16; ++i) { const int k = (i < 8 ? 0 : 512) + 8 * lane + (i & 7);
        const f32x4 a = *(const f32x4*)(w_in + (size_t)k * 2056 + 1536), b = *(const f32x4*)(w_in + (size_t)k * 2056 + 1540);
        wg[i][0] = a[0]; wg[i][1] = a[1]; wg[i][2] = a[2]; wg[i][3] = a[3]; wg[i][4] = b[0]; wg[i][5] = b[1]; wg[i][6] = b[2]; wg[i][7] = b[3]; }
    float gg[16];
#pragma unroll
    for (int q = 0; q < 4; ++q) { const f32x4 t = *(const f32x4*)(g1 + (q >> 1) * 512 + 8 * lane + (q & 1) * 4); gg[4 * q] = t[0]; gg[4 * q + 1] = t[1]; gg[4 * q + 2] = t[2]; gg[4 * q + 3] = t[3]; }
    for (int row = blockIdx.x * 8 + F.wave; row < T_TOK; row += F.G * 8) {
        const int b = row >> 12;
        float hv[16];
#pragma unroll
        for (int q = 0; q < 4; ++q) { const int off = (q >> 1) * 512 + 8 * lane + (q & 1) * 4;
            const f32x4 t = *(const f32x4*)(x + (size_t)row * 1024 + off);
#pragma unroll
            for (int j = 0; j < 4; ++j) hv[4 * q + j] = t[j]; }
        float ss = 0.f;
#pragma unroll
        for (int i = 0; i < 16; ++i) ss += hv[i] * hv[i];
        ss = wave_sum(ss);
        const float r = rsqrtf(ss * (1.f / 1024.f) + 1e-6f);
#pragma unroll
        for (int q = 0; q < 4; ++q) { const int off = (q >> 1) * 512 + 8 * lane + (q & 1) * 4;
            const f32x4 s = *(const f32x4*)(mod + b * 6144 + 1024 + off), sh = *(const f32x4*)(mod + b * 6144 + off);
#pragma unroll
            for (int j = 0; j < 4; ++j) hv[4 * q + j] = hv[4 * q + j] * r * gg[4 * q + j] * (1.f + s[j]) + sh[j]; }
        u32x4 w0, w1;
        w0.x = pk2(hv[0], hv[1]); w0.y = pk2(hv[2], hv[3]); w0.z = pk2(hv[4], hv[5]); w0.w = pk2(hv[6], hv[7]);
        w1.x = pk2(hv[8], hv[9]); w1.y = pk2(hv[10], hv[11]); w1.z = pk2(hv[12], hv[13]); w1.w = pk2(hv[14], hv[15]);
        *(u32x4*)(h + (size_t)row * 1024 + 8 * lane) = w0;
        *(u32x4*)(h + (size_t)row * 1024 + 512 + 8 * lane) = w1;
        float ga[8];
#pragma unroll
        for (int j = 0; j < 8; ++j) { float a = 0.f;
#pragma unroll
            for (int i = 0; i < 16; ++i) a += hv[i] * wg[i][j];
            ga[j] = wave_sum(a); }
        if (lane == 0) { *(f32x4*)(gif + (size_t)row * 8) = (f32x4){ga[0], ga[1], ga[2], ga[3]}; *(f32x4*)(gif + (size_t)row * 8 + 4) = (f32x4){ga[4], ga[5], ga[6], ga[7]}; }
    }
}

struct MkEpiBf16 {
    static constexpr bool PERM = true;
    bf16* O; int ldc;
    __device__ __forceinline__ void operator()(const f32x4 (&acc)[2][2][4][2], const pg8::Unit& u, int wr, int wc, int fr, int fq) const {
        const int row0 = u.pm * 256 + wr * 64 + fr, col0 = u.pn * 256 + wc * 32 + 8 * fq;
#pragma unroll
        for (int ai = 0; ai < 2; ++ai)
#pragma unroll
            for (int m = 0; m < 4; ++m) { bf16* rowp = O + (size_t)(row0 + ai * 128 + m * 16) * ldc + col0;
#pragma unroll
                for (int bj = 0; bj < 2; ++bj) { const f32x4 v0 = acc[ai][bj][m][0], v1 = acc[ai][bj][m][1];
                    u32x4 w; w.x = pk2(v0[0], v0[1]); w.y = pk2(v0[2], v0[3]); w.z = pk2(v1[0], v1[1]); w.w = pk2(v1[2], v1[3]);
                    *(u32x4*)(rowp + bj * 128) = w; } }
    }
};


struct MkEpiResid {
    static constexpr bool PERM = false;
    const float* x; const float* mod; float* x1;
    __device__ __forceinline__ void operator()(const f32x4 (&acc)[2][2][4][2], const pg8::Unit& u, int wr, int wc, int fr, int fq) const {
        const int row0 = u.pm * 256 + wr * 64 + fr, col0 = u.pn * 256 + wc * 32 + 4 * fq;
        const float* ga = mod + (u.pm >> 4) * 6144 + 2 * 1024 + col0;
        f32x4 gv[2][2];
#pragma unroll
        for (int bj = 0; bj < 2; ++bj)
#pragma unroll
            for (int n = 0; n < 2; ++n) gv[bj][n] = *(const f32x4*)(ga + bj * 128 + n * 16);
#pragma unroll
        for (int ai = 0; ai < 2; ++ai)
#pragma unroll
            for (int m = 0; m < 4; ++m) { const size_t ro = (size_t)(row0 + ai * 128 + m * 16) * 1024 + col0;
#pragma unroll
                for (int bj = 0; bj < 2; ++bj)
#pragma unroll
                    for (int n = 0; n < 2; ++n) { const f32x4 xv = *(const f32x4*)(x + ro + bj * 128 + n * 16);
                        *(f32x4*)(x1 + ro + bj * 128 + n * 16) = xv + gv[bj][n] * acc[ai][bj][m][n]; } }
    }
};

typedef short bf16x8 __attribute__((ext_vector_type(8)));
constexpr int P6_XT = 0, P6_GP = 65792, P6_SH = 69888, P6_PART = 73984, P6_SSP = 98560, P6_LOG = 99072, P6_CONST = 102144, P6_RINV = 102336,
              P6_LCNT = 102400, P6_LBASE = 102528, P6_APOS = 102656, P6_AEXP = 103680;
__device__ __forceinline__ void p6_router_group(const Frame& F, int grp) {
    const float* x1 = F.out; const float* g2 = F.in[18]; const float* w_rg = F.in[19]; const float* b_rg = F.in[20]; const float* w_re = F.in[21]; const float* b_re = F.in[22];
    const float* mod = (const float*)(F.ws + WS_MOD);
    bf16* h2 = (bf16*)(F.ws + WS_ACT1);
    float* asg_gate = (float*)(F.ws + WS_ASGG); int* list = (int*)(F.ws + WS_LIST); unsigned* cnt = F.ctl + CW_CNT;
    LAS float* XT = (LAS float*)(F.lds + P6_XT); LAS float* GP = (LAS float*)(F.lds + P6_GP); LAS float* SH = (LAS float*)(F.lds + P6_SH);
    LAS float* PART = (LAS float*)(F.lds + P6_PART); LAS float* SSP = (LAS float*)(F.lds + P6_SSP); LAS float* LOG = (LAS float*)(F.lds + P6_LOG);
    LAS float* CONST = (LAS float*)(F.lds + P6_CONST); LAS float* RINV = (LAS float*)(F.lds + P6_RINV);
    LAS int* LCNT = (LAS int*)(F.lds + P6_LCNT); LAS int* LBASE = (LAS int*)(F.lds + P6_LBASE); LAS int* APOS = (LAS int*)(F.lds + P6_APOS); LAS int* AEXP = (LAS int*)(F.lds + P6_AEXP);
    const int tid = F.tid, lane = F.lane, w = F.wave, tok0 = grp * 128, b = tok0 >> 12;
    const int tl = lane & 15, g = lane >> 4;
    for (int k = tid; k < 1024; k += 512) { GP[k] = g2[k] * (1.f + mod[b * 6144 + 4 * 1024 + k]); SH[k] = mod[b * 6144 + 3 * 1024 + k]; }
    if (tid < 32) LCNT[tid] = 0;
    if (tid < 48) CONST[tid] = 0.f;
    __syncthreads();
    if (tid < 288) {
        const int c = tid >> 3, part = tid & 7; float s = 0.f;
        for (int k = part * 128; k < part * 128 + 128; ++k) s += SH[k] * (c < 4 ? w_rg[k * 4 + c] : w_re[k * 32 + (c - 4)]);
        s += __shfl_xor(s, 1); s += __shfl_xor(s, 2); s += __shfl_xor(s, 4);
        if (part == 0) CONST[c] = s + (c < 4 ? b_rg[c] : b_re[c - 4]);
    }
    bf16x8 Bhi[3][4], Blo[3][4];
    { const u32x4* wr = (const u32x4*)(F.ws + WS_WR) + ((size_t)b * 8 + w) * 3 * 4 * 2 * 64 + lane;
#pragma unroll
      for (int nt = 0; nt < 3; ++nt)
#pragma unroll
        for (int s = 0; s < 4; ++s) { Bhi[nt][s] = __builtin_bit_cast(bf16x8, wr[((nt * 4 + s) * 2 + 0) * 64]); Blo[nt][s] = __builtin_bit_cast(bf16x8, wr[((nt * 4 + s) * 2 + 1) * 64]); } }
    for (int it = 0; it < 8; ++it) {
        const int tok = tok0 + 16 * it;
        f32x4 ld[8];
#pragma unroll
        for (int p = 0; p < 8; ++p) { const int idx = tid + 512 * p, row = idx >> 8, c4 = idx & 255; ld[p] = *(const f32x4*)(x1 + (size_t)(tok + row) * 1024 + 4 * c4); }
#pragma unroll
        for (int p = 0; p < 8; ++p) { const int idx = tid + 512 * p, row = idx >> 8, c4 = idx & 255; *(LAS f32x4*)(XT + row * 1028 + 4 * c4) = ld[p]; }
        __syncthreads();
        f32x4 acc[3];
#pragma unroll
        for (int nt = 0; nt < 3; ++nt) acc[nt] = (f32x4){0.f, 0.f, 0.f, 0.f};
        float ssp = 0.f;
#pragma unroll
        for (int s = 0; s < 4; ++s) {
            const f32x4 a0 = *(const LAS f32x4*)(XT + tl * 1028 + 128 * w + 32 * s + 8 * g), a1 = *(const LAS f32x4*)(XT + tl * 1028 + 128 * w + 32 * s + 8 * g + 4);
            const float a[8] = {a0[0], a0[1], a0[2], a0[3], a1[0], a1[1], a1[2], a1[3]};
#pragma unroll
            for (int j = 0; j < 8; ++j) ssp += a[j] * a[j];
            u32x4 ahi_, alo_; split_hi_lo(a, ahi_, alo_); const bf16x8 Ahi = __builtin_bit_cast(bf16x8, ahi_), Alo = __builtin_bit_cast(bf16x8, alo_);
#pragma unroll
            for (int nt = 0; nt < 3; ++nt) {
                acc[nt] = __builtin_amdgcn_mfma_f32_16x16x32_bf16(Ahi, Bhi[nt][s], acc[nt], 0, 0, 0);
                acc[nt] = __builtin_amdgcn_mfma_f32_16x16x32_bf16(Ahi, Blo[nt][s], acc[nt], 0, 0, 0);
                acc[nt] = __builtin_amdgcn_mfma_f32_16x16x32_bf16(Alo, Bhi[nt][s], acc[nt], 0, 0, 0);
            }
        }
        ssp += __shfl_xor(ssp, 16); ssp += __shfl_xor(ssp, 32);
        if (g == 0) SSP[w * 16 + tl] = ssp;
#pragma unroll
        for (int nt = 0; nt < 3; ++nt)
#pragma unroll
            for (int r = 0; r < 4; ++r) PART[(w * 16 + 4 * g + r) * 48 + 16 * nt + tl] = acc[nt][r];
        __syncthreads();
        for (int idx = tid; idx < 768; idx += 512) { const int t = idx / 48, c = idx - t * 48;
            float s = 0.f, ss = 0.f;
#pragma unroll
            for (int ww = 0; ww < 8; ++ww) { s += PART[(ww * 16 + t) * 48 + c]; ss += SSP[ww * 16 + t]; }
            const float r = rsqrtf(ss * (1.f / 1024.f) + 1e-6f);
            LOG[t * 48 + c] = r * s + CONST[c];
            if (c == 0) RINV[t] = r; }
        __syncthreads();
        if (tid < 16) {
            const LAS float* lg = LOG + tid * 48;
            int gi = 0; float gmax = lg[0];
#pragma unroll
            for (int i = 1; i < 4; ++i) { const float v = lg[i]; if (v > gmax) { gmax = v; gi = i; } }
            float den = 0.f;
#pragma unroll
            for (int i = 0; i < 4; ++i) den += __expf(lg[i] - gmax);
            const float ggate = 1.f / den;
            int i0 = 0; float v0 = lg[4 + gi * 8];
#pragma unroll
            for (int i = 1; i < 8; ++i) { const float v = lg[4 + gi * 8 + i]; if (v > v0) { v0 = v; i0 = i; } }
            int i1 = -1; float v1 = 0.f;
#pragma unroll
            for (int i = 0; i < 8; ++i) { const float v = lg[4 + gi * 8 + i]; if (i != i0 && (i1 < 0 || v > v1)) { v1 = v; i1 = i; } }
            const float ex = __expf(v1 - v0);
            const float p0 = 1.f / (1.f + ex), p1 = ex / (1.f + ex);
            const int e0 = gi * 8 + i0, e1 = gi * 8 + i1, aid = 2 * (tok + tid);
            *(float2*)(asg_gate + aid) = make_float2(p0 * ggate, p1 * ggate);
            const int j = it * 32 + 2 * tid;
            AEXP[j] = e0; AEXP[j + 1] = e1;
            APOS[j] = __hip_atomic_fetch_add(&LCNT[e0], 1, __ATOMIC_RELAXED, __HIP_MEMORY_SCOPE_WORKGROUP); APOS[j + 1] = __hip_atomic_fetch_add(&LCNT[e1], 1, __ATOMIC_RELAXED, __HIP_MEMORY_SCOPE_WORKGROUP);
        }
        {
            const int row = tid >> 5; const float r = RINV[row];
#pragma unroll
            for (int q = 0; q < 4; ++q) { const int col = 8 * (tid & 31) + 256 * q;
                const f32x4 x0 = *(const LAS f32x4*)(XT + row * 1028 + col), x1v = *(const LAS f32x4*)(XT + row * 1028 + col + 4);
                const f32x4 p0 = *(const LAS f32x4*)(GP + col), p1 = *(const LAS f32x4*)(GP + col + 4), s0 = *(const LAS f32x4*)(SH + col), s1 = *(const LAS f32x4*)(SH + col + 4);
                const f32x4 y0 = x0 * r * p0 + s0, y1 = x1v * r * p1 + s1;
                u32x4 o; o.x = pk2(y0[0], y0[1]); o.y = pk2(y0[2], y0[3]); o.z = pk2(y1[0], y1[1]); o.w = pk2(y1[2], y1[3]);
                *(u32x4*)(h2 + (size_t)(tok + row) * 1024 + col) = o; }
        }
        __syncthreads();
    }
    if (tid < 32) LBASE[tid] = (int)atomicAdd(cnt + tid, (unsigned)LCNT[tid]);
    __syncthreads();
    if (tid < 256) { const int e = AEXP[tid], pos = LBASE[e] + APOS[tid];
        const int aid = 2 * (tok0 + (tid >> 5) * 16 + ((tid & 31) >> 1)) + (tid & 1);
        list[e * CAPX + pos] = aid; }
    __syncthreads();
}

__device__ __forceinline__ void moe_table(const Frame& F) {
    LAS int* ts = (LAS int*)(F.lds + MOE_OFF); LAS int* cn = ts + 33;
    if (F.tid == 0) { int acc = 0; for (int e = 0; e < 32; ++e) { const int c = (int)__hip_atomic_load(F.ctl + CW_CNT + e, RLX_AGENT); cn[e] = c; ts[e] = acc; acc += (c + 255) >> 8; } ts[32] = acc; }
    __syncthreads();
}
struct MoeOrder {
    const char* Abase; const char* Bbase; const int* list; LAS int* ts; LAS int* cn; int K; size_t strideB_e; int G, c; bool gather;
    __device__ __forceinline__ bool next(int i, pg8::Unit& u) const {
        const int total = __builtin_amdgcn_readfirstlane(ts[32]) * 4;
        const int L = i * G + c; if (L >= total) return false;
        const int mg = L >> 2, pn = L & 3;
        int e = 0;
        for (int j = 1; j < 32; ++j) e += (ts[j] <= mg) ? 1 : 0;
        e = __builtin_amdgcn_readfirstlane(e);
        const int mt = mg - __builtin_amdgcn_readfirstlane(ts[e]); const int ce = __builtin_amdgcn_readfirstlane(cn[e]);
        u.pm = mg; u.pn = pn; u.e = e * CAPX + mt * 256; u.nvalid = (ce - mt * 256 < 256) ? (ce - mt * 256) : 256;
        u.A = gather ? Abase : Abase + (size_t)mg * 256 * K * 2;
        u.B = Bbase + (size_t)e * strideB_e + (size_t)pn * 256 * K * 2;
        return true;
    }
    __device__ __forceinline__ unsigned a_row_off(const pg8::Unit& u, int r) const {
        if (!gather) return (unsigned)(r * K * 2);
        const int a = (r < u.nvalid) ? list[u.e + r] : 0;
        return (unsigned)(a >> 1) * (unsigned)(K * 2);
    }
    __device__ __forceinline__ void a_ready(const pg8::Unit&) const {}
    __device__ __forceinline__ void done(const pg8::Unit&) const {}
};
struct MkEpiSwiglu {
    static constexpr bool PERM = true;
    bf16* H;
    __device__ __forceinline__ void operator()(const f32x4 (&acc)[2][2][4][2], const pg8::Unit& u, int wr, int wc, int fr, int fq) const {
        const int row0 = u.pm * 256 + wr * 64 + fr, col0 = u.pn * 128 + wc * 32 + 8 * fq;
#pragma unroll
        for (int ai = 0; ai < 2; ++ai)
#pragma unroll
            for (int m = 0; m < 4; ++m) {
                float hv[8];
#pragma unroll
                for (int n = 0; n < 2; ++n)
#pragma unroll
                    for (int j = 0; j < 4; ++j) { const float gt = acc[ai][0][m][n][j], up = acc[ai][1][m][n][j]; hv[4 * n + j] = gt / (1.f + __expf(-gt)) * up; }
                u32x4 o; o.x = pk2(hv[0], hv[1]); o.y = pk2(hv[2], hv[3]); o.z = pk2(hv[4], hv[5]); o.w = pk2(hv[6], hv[7]);
                *(u32x4*)(H + (size_t)(row0 + ai * 128 + m * 16) * 512 + col0) = o; }
    }
};
struct MkEpiSlot {
    static constexpr bool PERM = true;
    bf16* slot; const int* list; const float* gate;
    __device__ __forceinline__ void operator()(const f32x4 (&acc)[2][2][4][2], const pg8::Unit& u, int wr, int wc, int fr, int fq) const {
        const int col0 = u.pn * 256 + wc * 32 + 8 * fq;
#pragma unroll
        for (int ai = 0; ai < 2; ++ai)
#pragma unroll
            for (int m = 0; m < 4; ++m) { const int r = ai * 128 + wr * 64 + m * 16 + fr;
                if (r < u.nvalid) { const int aid = list[u.e + r]; const float gt = gate[aid]; bf16* rowp = slot + (size_t)aid * 1024 + col0;
#pragma unroll
                    for (int bj = 0; bj < 2; ++bj) { const f32x4 v0 = acc[ai][bj][m][0] * gt, v1 = acc[ai][bj][m][1] * gt;
                        u32x4 o; o.x = pk2(v0[0], v0[1]); o.y = pk2(v0[2], v0[3]); o.z = pk2(v1[0], v1[1]); o.w = pk2(v1[2], v1[3]);
                        *(u32x4*)(rowp + bj * 128) = o; } } }
    }
};

__device__ __forceinline__ void p9_final(const Frame& F) {
    float* xo = F.out; const bf16* slot = (const bf16*)(F.ws + WS_SLOT); const float* mod = (const float*)(F.ws + WS_MOD); const float* fg = F.in[26];
    const int lane = F.lane;
    for (int row = blockIdx.x * 8 + F.wave; row < T_TOK; row += F.G * 8) {
        const int b = row >> 12;
        float v[16];
#pragma unroll
        for (int q = 0; q < 2; ++q) { const int off = q * 512 + 8 * lane;
            const f32x4 t0 = *(const f32x4*)(xo + (size_t)row * 1024 + off), t1 = *(const f32x4*)(xo + (size_t)row * 1024 + off + 4);
            const f32x4 g0 = *(const f32x4*)(mod + b * 6144 + 5 * 1024 + off), g1 = *(const f32x4*)(mod + b * 6144 + 5 * 1024 + off + 4);
            const u32x4 sa = *(const u32x4*)(slot + (size_t)(2 * row) * 1024 + off), sb = *(const u32x4*)(slot + (size_t)(2 * row + 1) * 1024 + off);
            float m[8];
#pragma unroll
            for (int j = 0; j < 4; ++j) { m[2 * j] = __builtin_bit_cast(float, sa[j] << 16) + __builtin_bit_cast(float, sb[j] << 16);
                m[2 * j + 1] = __builtin_bit_cast(float, sa[j] & 0xffff0000u) + __builtin_bit_cast(float, sb[j] & 0xffff0000u); }
#pragma unroll
            for (int j = 0; j < 4; ++j) { v[8 * q + j] = t0[j] + g0[j] * m[j]; v[8 * q + 4 + j] = t1[j] + g1[j] * m[4 + j]; } }
        float ss = 0.f;
#pragma unroll
        for (int i = 0; i < 16; ++i) ss += v[i] * v[i];
        ss = wave_sum(ss);
        const float r = rsqrtf(ss * (1.f / 1024.f) + 1e-6f);
#pragma unroll
        for (int q = 0; q < 2; ++q) { const int off = q * 512 + 8 * lane;
            const f32x4 f0 = *(const f32x4*)(fg + off), f1 = *(const f32x4*)(fg + off + 4);
            f32x4 o0, o1;
#pragma unroll
            for (int j = 0; j < 4; ++j) { o0[j] = v[8 * q + j] * r * f0[j]; o1[j] = v[8 * q + 4 + j] * r * f1[j]; }
#ifdef DIAG_ZERO_ROWS
            if (row < DIAG_ZERO_ROWS) { o0 = (f32x4){0.f, 0.f, 0.f, 0.f}; o1 = o0; }
#endif
            *(f32x4*)(xo + (size_t)row * 1024 + off) = o0; *(f32x4*)(xo + (size_t)row * 1024 + off + 4) = o1; }
    }
}

typedef short s16x4 __attribute__((ext_vector_type(4)));
typedef unsigned u32x2 __attribute__((ext_vector_type(2)));
constexpr int TP = 272;
constexpr int TILE_B = 64 * TP;
constexpr int SP_ = 144;
constexpr size_t WS_UC = 304 * MiB, WS_Q = 336 * MiB, WS_K = 368 * MiB;
constexpr size_t WS_STATE = 400 * MiB; constexpr int STATE_STRIDE = 66560;
constexpr float NEG_BIG = -1e30f;

__device__ __forceinline__ bf16x8 frag_row(const LAS unsigned char* tile, int pitch, int row, int col) { return *(const LAS bf16x8*)(tile + row * pitch + col * 2); }
__device__ __forceinline__ bf16x8 frag_tr(const LAS unsigned char* tile, int ks, int c, int lane) {
    const int g = lane >> 4, q = (lane & 15) >> 2, p = lane & 3;
    const LAS unsigned char* a0 = tile + (32 * ks + 8 * g + q) * TP + (16 * c + 4 * p) * 2;
    const s16x4 lo = __builtin_amdgcn_ds_read_tr16_b64_v4i16((LAS s16x4*)a0);
    const s16x4 hi = __builtin_amdgcn_ds_read_tr16_b64_v4i16((LAS s16x4*)(a0 + 4 * TP));
    bf16x8 r; r[0] = lo[0]; r[1] = lo[1]; r[2] = lo[2]; r[3] = lo[3]; r[4] = hi[0]; r[5] = hi[1]; r[6] = hi[2]; r[7] = hi[3]; return r;
}
__device__ __forceinline__ void tile_load(const Frame& F, LAS unsigned char* tile, const bf16* src, int ld) {
    const int row = F.tid >> 3, seg = F.tid & 7;
    const u32x4 a = *(const u32x4*)(src + (size_t)row * ld + seg * 16), b = *(const u32x4*)(src + (size_t)row * ld + seg * 16 + 8);
    *(LAS u32x4*)(tile + row * TP + seg * 32) = a; *(LAS u32x4*)(tile + row * TP + seg * 32 + 16) = b;
}
__device__ __forceinline__ void tile_store(const Frame& F, const LAS unsigned char* tile, bf16* dst, int ld) {
    const int row = F.tid >> 3, seg = F.tid & 7;
    const u32x4 a = *(const LAS u32x4*)(tile + row * TP + seg * 32), b = *(const LAS u32x4*)(tile + row * TP + seg * 32 + 16);
    *(u32x4*)(dst + (size_t)row * ld + seg * 16) = a; *(u32x4*)(dst + (size_t)row * ld + seg * 16 + 8) = b;
}
__device__ __forceinline__ void unpack8(const u32x4 v, float (&f)[8]) {
#pragma unroll
    for (int j = 0; j < 4; ++j) { f[2 * j] = __builtin_bit_cast(float, v[j] << 16); f[2 * j + 1] = __builtin_bit_cast(float, v[j] & 0xffff0000u); }
}
__device__ __forceinline__ u32x4 pack8(const float (&f)[8]) { u32x4 o; o.x = pk2(f[0], f[1]); o.y = pk2(f[2], f[3]); o.z = pk2(f[4], f[5]); o.w = pk2(f[6], f[7]); return o; }
__device__ __forceinline__ float log_sigmoid_f(float f) { return fminf(f, 0.f) - log1pf(__expf(-fabsf(f))); }

struct ChunkGates { float c, b, pm, b_last, pm_last; };
__device__ __forceinline__ ChunkGates chunk_gates(const float* gif, int tok, int h, float bi, float bfg, float m_prev, int lane) {
    ChunkGates G;
    const float ig = gif[(size_t)(tok + lane) * 8 + h] + bi;
    float b = log_sigmoid_f(gif[(size_t)(tok + lane) * 8 + 4 + h] + bfg);
#pragma unroll
    for (int o = 1; o < 64; o <<= 1) { const float v = __shfl_up(b, o); if (lane >= o) b += v; }
    const float c = ig - b;
    float pm = c;
#pragma unroll
    for (int o = 1; o < 64; o <<= 1) { const float v = __shfl_up(pm, o); if (lane >= o) pm = fmaxf(pm, v); }
    pm = fmaxf(pm, m_prev);
    G.c = c; G.b = b; G.pm = pm; G.b_last = __shfl(b, 63); G.pm_last = __shfl(pm, 63);
    return G;
}
__device__ __forceinline__ void state_update(const LAS unsigned char* Kt, const LAS unsigned char* Vt, f32x4 (&Ct)[8], f32x4& nacc, const ChunkGates& G, float m_prev, int w, int lane) {
    const int tl = lane & 15, gq = lane >> 4;
    const float a_prev = __expf(m_prev - G.pm_last);
    const float ws = __expf(G.c - G.pm_last);
#pragma unroll
    for (int dt = 0; dt < 8; ++dt) Ct[dt] = Ct[dt] * a_prev;
    nacc = nacc * a_prev;
#pragma unroll
    for (int ss = 0; ss < 2; ++ss) {
        float wj[8];
#pragma unroll
        for (int j = 0; j < 8; ++j) wj[j] = __shfl(ws, 32 * ss + 8 * gq + j);
        const bf16x8 vraw = frag_tr(Vt, ss, w, lane);
        float vf[8]; unpack8(__builtin_bit_cast(u32x4, vraw), vf);
        float wcol[8];
#pragma unroll
        for (int j = 0; j < 8; ++j) { vf[j] *= wj[j]; wcol[j] = (tl == 0) ? wj[j] : 0.f; }
        const bf16x8 vw = __builtin_bit_cast(bf16x8, pack8(vf)), wc = __builtin_bit_cast(bf16x8, pack8(wcol));
#pragma unroll
        for (int dt = 0; dt < 8; ++dt) { const bf16x8 kf = frag_tr(Kt, ss, dt, lane);
            Ct[dt] = __builtin_amdgcn_mfma_f32_16x16x32_bf16(kf, vw, Ct[dt], 0, 0, 0);
            if (dt == w) nacc = __builtin_amdgcn_mfma_f32_16x16x32_bf16(kf, wc, nacc, 0, 0, 0); }
    }
}

constexpr int P3_UC = 0, P3_V = TILE_B, P3_PH = 2 * TILE_B, P3_Q = 2 * TILE_B + 80 * TP, P3_K = P3_Q + TILE_B, P3_PO = P3_K + TILE_B, P3_Y = P3_PO + TILE_B, P3_CW = P3_Y + TILE_B;
static_assert(P3_CW + 5 * 128 * 4 <= RING_BYTES, "P3 LDS map");
__device__ __forceinline__ void p3_unit(const Frame& F, int unit) {
    const int b = unit >> 5, sp = (unit >> 2) & 7, g = unit & 3;
    const int tid = F.tid, lane = F.lane, w = F.wave, tl = lane & 15, gq = lane >> 4;
    const bf16* proj = F.proj; const float* gif = (const float*)(F.ws + WS_GIF);
    bf16* ucg = (bf16*)(F.ws + WS_UC); bf16* qg = (bf16*)(F.ws + WS_Q); bf16* kg = (bf16*)(F.ws + WS_K); bf16* yg = (bf16*)(F.ws + WS_ACT1);
    LAS unsigned char* L = F.lds;
#ifdef DIAG_ZERO_LDS
    for (int i = F.tid; i < RING_BYTES / 16; i += 512) *(LAS u32x4*)(L + i * 16) = (u32x4){0u, 0u, 0u, 0u};
    __syncthreads();
#endif
    LAS float* CW = (LAS float*)(L + P3_CW);
    if (tid < 128) { CW[4 * 128 + tid] = F.in[7][g * 128 + tid]; }
    { const int j = tid >> 7, c = tid & 127; CW[j * 128 + c] = F.in[6][j * 512 + g * 128 + c]; }
    bf16x8 Wq[4], Wk[4], Wp[4];
#pragma unroll
    for (int s = 0; s < 4; ++s) { const size_t o = (size_t)g * 16384 + (size_t)(16 * w + tl) * 128 + 32 * s + 8 * gq;
        Wq[s] = *(const bf16x8*)((const bf16*)(F.ws + WS_WQ) + o); Wk[s] = *(const bf16x8*)((const bf16*)(F.ws + WS_WK) + o); Wp[s] = *(const bf16x8*)((const bf16*)(F.ws + WS_WPOOL) + o); }
    const f32x4 bp = *(const f32x4*)(F.in[15] + g * 128 + 16 * w + 4 * gq), ps = *(const f32x4*)(F.in[16] + g * 128 + 16 * w + 4 * gq);
    const float bi = F.in[10][g], bfg = F.in[11][g];
    f32x4 Ct[8]; f32x4 nacc = (f32x4){0.f, 0.f, 0.f, 0.f};
#pragma unroll
    for (int dt = 0; dt < 8; ++dt) Ct[dt] = (f32x4){0.f, 0.f, 0.f, 0.f};
    float m = NEG_BIG, btot = 0.f;
    const int win = 2 << g;
    __syncthreads();
    for (int ch = 0; ch < 8; ++ch) {
        const int tt0 = sp * 512 + ch * 64, tok = b * 4096 + tt0;
        {
            const int row = tid >> 3, cg = tid & 7;
            float a[16];
#pragma unroll
            for (int i = 0; i < 16; ++i) a[i] = CW[4 * 128 + 16 * cg + i];
#pragma unroll
            for (int j = 0; j < 4; ++j) { const int tt = tt0 + row - 3 + j;
                if (tt >= 0) { const bf16* src = proj + (size_t)(tok + row - 3 + j) * 2048 + g * 128 + 16 * cg;
                    float x0[8], x1[8]; unpack8(*(const u32x4*)src, x0); unpack8(*(const u32x4*)(src + 8), x1);
#pragma unroll
                    for (int i = 0; i < 8; ++i) { a[i] += CW[j * 128 + 16 * cg + i] * x0[i]; a[8 + i] += CW[j * 128 + 16 * cg + 8 + i] * x1[i]; } } }
            float o0[8], o1[8];
#pragma unroll
            for (int i = 0; i < 8; ++i) { o0[i] = silu_f(a[i]); o1[i] = silu_f(a[8 + i]); }
            const u32x4 u0 = pack8(o0), u1 = pack8(o1);
            *(LAS u32x4*)(L + P3_UC + row * TP + cg * 32) = u0; *(LAS u32x4*)(L + P3_UC + row * TP + cg * 32 + 16) = u1;
            *(u32x4*)(ucg + (size_t)(tok + row) * 512 + g * 128 + 16 * cg) = u0; *(u32x4*)(ucg + (size_t)(tok + row) * 512 + g * 128 + 16 * cg + 8) = u1;
            tile_load(F, L + P3_V, proj + (size_t)tok * 2048 + 512 + g * 128, 2048);
            for (int idx = tid; idx < 79 * 8; idx += 512) { const int r = idx >> 3, seg = idx & 7; const int tt = tt0 - 15 + r;
                u32x4 v0 = {0u, 0u, 0u, 0u}, v1 = {0u, 0u, 0u, 0u};
                if (tt >= 0) { const bf16* src = proj + (size_t)(tok - 15 + r) * 2048 + 1536 + g * 128 + seg * 16; v0 = *(const u32x4*)src; v1 = *(const u32x4*)(src + 8); }
                *(LAS u32x4*)(L + P3_PH + r * TP + seg * 32) = v0; *(LAS u32x4*)(L + P3_PH + r * TP + seg * 32 + 16) = v1; }
        }
        __syncthreads();
        {
            f32x4 aq[4], ak[4];
#pragma unroll
            for (int mt = 0; mt < 4; ++mt) { aq[mt] = (f32x4){0.f, 0.f, 0.f, 0.f}; ak[mt] = (f32x4){0.f, 0.f, 0.f, 0.f}; }
#pragma unroll
            for (int mt = 0; mt < 4; ++mt)
#pragma unroll
                for (int s = 0; s < 4; ++s) { const bf16x8 uf = frag_row(L + P3_UC, TP, 16 * mt + tl, 32 * s + 8 * gq);
                    aq[mt] = __builtin_amdgcn_mfma_f32_16x16x32_bf16(Wq[s], uf, aq[mt], 0, 0, 0);
                    ak[mt] = __builtin_amdgcn_mfma_f32_16x16x32_bf16(Wk[s], uf, ak[mt], 0, 0, 0); }
#pragma unroll
            for (int mt = 0; mt < 4; ++mt) { const float qs = 0.08838834764831845f;
                u32x2 qv, kv; qv.x = pk2(aq[mt][0] * qs, aq[mt][1] * qs); qv.y = pk2(aq[mt][2] * qs, aq[mt][3] * qs); kv.x = pk2(ak[mt][0], ak[mt][1]); kv.y = pk2(ak[mt][2], ak[mt][3]);
                *(LAS u32x2*)(L + P3_Q + (16 * mt + tl) * TP + (16 * w + 4 * gq) * 2) = qv; *(LAS u32x2*)(L + P3_K + (16 * mt + tl) * TP + (16 * w + 4 * gq) * 2) = kv; }
            const int row = tid >> 3, cg = tid & 7, tt = tt0 + row;
            const int cntw = (tt + 1 < win) ? (tt + 1) : win;
            float s0[8], s1[8];
#pragma unroll
            for (int i = 0; i < 8; ++i) { s0[i] = 0.f; s1[i] = 0.f; }
            for (int j = 0; j < cntw; ++j) { float x0[8], x1[8];
                unpack8(*(const LAS u32x4*)(L + P3_PH + (row + 15 - j) * TP + cg * 32), x0); unpack8(*(const LAS u32x4*)(L + P3_PH + (row + 15 - j) * TP + cg * 32 + 16), x1);
#pragma unroll
                for (int i = 0; i < 8; ++i) { s0[i] += x0[i]; s1[i] += x1[i]; } }
            float c0[8], c1[8]; unpack8(*(const LAS u32x4*)(L + P3_PH + (row + 15) * TP + cg * 32), c0); unpack8(*(const LAS u32x4*)(L + P3_PH + (row + 15) * TP + cg * 32 + 16), c1);
            const float inv = 1.f / (float)cntw;
#pragma unroll
            for (int i = 0; i < 8; ++i) { s0[i] = s0[i] * inv - c0[i]; s1[i] = s1[i] * inv - c1[i]; }
            *(LAS u32x4*)(L + P3_PO + row * TP + cg * 32) = pack8(s0); *(LAS u32x4*)(L + P3_PO + row * TP + cg * 32 + 16) = pack8(s1);
        }
        __syncthreads();
        {
            tile_store(F, L + P3_Q, qg + (size_t)tok * 512 + g * 128, 512);
            tile_store(F, L + P3_K, kg + (size_t)tok * 512 + g * 128, 512);
            f32x4 ap[4];
#pragma unroll
            for (int mt = 0; mt < 4; ++mt) ap[mt] = (f32x4){0.f, 0.f, 0.f, 0.f};
#pragma unroll
            for (int mt = 0; mt < 4; ++mt)
#pragma unroll
                for (int s = 0; s < 4; ++s) ap[mt] = __builtin_amdgcn_mfma_f32_16x16x32_bf16(Wp[s], frag_row(L + P3_PO, TP, 16 * mt + tl, 32 * s + 8 * gq), ap[mt], 0, 0, 0);
#pragma unroll
            for (int mt = 0; mt < 4; ++mt) { const f32x4 y = (ap[mt] + bp) * ps; u32x2 yv; yv.x = pk2(y[0], y[1]); yv.y = pk2(y[2], y[3]);
                *(LAS u32x2*)(L + P3_Y + (16 * mt + tl) * TP + (16 * w + 4 * gq) * 2) = yv; }
            const ChunkGates G = chunk_gates(gif, tok, g, bi, bfg, m, lane);
            state_update(L + P3_K, L + P3_V, Ct, nacc, G, m, w, lane);
            m = G.b_last + G.pm_last; btot += G.b_last;
        }
        __syncthreads();
        tile_store(F, L + P3_Y, yg + (size_t)tok * 1024 + 512 + g * 128, 1024);
    }
    unsigned char* st = F.ws + WS_STATE + (size_t)unit * STATE_STRIDE;
#pragma unroll
    for (int dt = 0; dt < 8; ++dt) *(f32x4*)(st + ((size_t)(w * 8 + dt) * 64 + lane) * 16) = Ct[dt];
    if (tl == 0) *(f32x4*)(st + 65536 + (16 * w + 4 * gq) * 4) = nacc;
    if (tid == 0) { *(float*)(st + 66048) = m; *(float*)(st + 66052) = btot; }
    __syncthreads();
}

constexpr int P4_Q = 0, P4_K = TILE_B, P4_V = 2 * TILE_B, P4_UC = 3 * TILE_B, P4_O = 4 * TILE_B, P4_Y = 5 * TILE_B, P4_S = 6 * TILE_B, P4_RS = P4_S + 64 * SP_, P4_QN = P4_RS + 512, P4_SSQ = P4_QN + 256, P4_NV = P4_SSQ + 2048;
static_assert(P4_NV + 256 <= RING_BYTES, "P4 LDS map");
__device__ __forceinline__ void p4_unit(const Frame& F, int unit, bf16* yg) {
    const int b = unit >> 5, sp = (unit >> 2) & 7, h = unit & 3;
    const int tid = F.tid, lane = F.lane, w = F.wave, tl = lane & 15, gq = lane >> 4;
    const bf16* proj = F.proj; const float* gif = (const float*)(F.ws + WS_GIF);
    const bf16* ucg = (const bf16*)(F.ws + WS_UC); const bf16* qg = (const bf16*)(F.ws + WS_Q); const bf16* kg = (const bf16*)(F.ws + WS_K);
    LAS unsigned char* L = F.lds;
#ifdef DIAG_ZERO_LDS
    for (int i = F.tid; i < RING_BYTES / 16; i += 512) *(LAS u32x4*)(L + i * 16) = (u32x4){0u, 0u, 0u, 0u};
    __syncthreads();
#endif
    LAS float* RS = (LAS float*)(L + P4_RS); LAS float* QN = (LAS float*)(L + P4_QN); LAS float* SSQ = (LAS float*)(L + P4_SSQ); LAS bf16* NV = (LAS bf16*)(L + P4_NV);
    const float bi = F.in[10][h], bfg = F.in[11][h];
    const f32x4 ng = *(const f32x4*)(F.in[12] + h * 128 + 16 * w + 4 * gq), sk = *(const f32x4*)(F.in[13] + h * 128 + 16 * w + 4 * gq);
    f32x4 Ct[8]; f32x4 nacc = (f32x4){0.f, 0.f, 0.f, 0.f};
#pragma unroll
    for (int dt = 0; dt < 8; ++dt) Ct[dt] = (f32x4){0.f, 0.f, 0.f, 0.f};
    float m = 0.f;
#ifdef DIAG_P4_NO_STATE
    for (int i = 0; i < 0; ++i) {
#else
    for (int i = 0; i < sp; ++i) {
#endif
        const unsigned char* st = F.ws + WS_STATE + (size_t)((b * 8 + i) * 4 + h) * STATE_STRIDE;
        const float mloc = *(const float*)(st + 66048), bt = *(const float*)(st + 66052);
        const float mn = fmaxf(bt + m, mloc), fa = __expf(bt + m - mn), fb = __expf(mloc - mn);
#pragma unroll
        for (int dt = 0; dt < 8; ++dt) Ct[dt] = Ct[dt] * fa + *(const f32x4*)(st + ((size_t)(w * 8 + dt) * 64 + lane) * 16) * fb;
        nacc = nacc * fa + *(const f32x4*)(st + 65536 + (16 * w + 4 * gq) * 4) * fb;
        m = mn;
    }
    if (tl == 0) { *(LAS u32x2*)(NV + 16 * w + 4 * gq) = (u32x2){pk2(nacc[0], nacc[1]), pk2(nacc[2], nacc[3])}; }
    __syncthreads();
    for (int ch = 0; ch < 8; ++ch) {
        const int tok = b * 4096 + sp * 512 + ch * 64;
        tile_load(F, L + P4_Q, qg + (size_t)tok * 512 + h * 128, 512);
        tile_load(F, L + P4_K, kg + (size_t)tok * 512 + h * 128, 512);
        tile_load(F, L + P4_UC, ucg + (size_t)tok * 512 + h * 128, 512);
        tile_load(F, L + P4_V, proj + (size_t)tok * 2048 + 512 + h * 128, 2048);
        tile_load(F, L + P4_O, proj + (size_t)tok * 2048 + 1024 + h * 128, 2048);
        const ChunkGates G = chunk_gates(gif, tok, h, bi, bfg, m, lane);
        __syncthreads();
        {
            const int mt = w >> 1, st0 = 2 * (w & 1);
            const float pmt = __shfl(G.pm, 16 * mt + tl);
            float rs = 0.f;
#pragma unroll
            for (int sti = 0; sti < 2; ++sti) { const int st = st0 + sti;
                f32x4 acc = (f32x4){0.f, 0.f, 0.f, 0.f};
                if (st <= mt) {
#pragma unroll
                    for (int ds = 0; ds < 4; ++ds) acc = __builtin_amdgcn_mfma_f32_16x16x32_bf16(frag_row(L + P4_K, TP, 16 * st + tl, 32 * ds + 8 * gq), frag_row(L + P4_Q, TP, 16 * mt + tl, 32 * ds + 8 * gq), acc, 0, 0, 0);
                }
                float v[4];
#pragma unroll
                for (int r = 0; r < 4; ++r) { const int s = 16 * st + 4 * gq + r, t = 16 * mt + tl; const float cs = __shfl(G.c, s);

#ifdef DIAG_P4_NOW
                    v[r] = (s <= t) ? acc[r] + 0.f * cs : 0.f; rs += v[r]; }
#else
                    v[r] = (s <= t) ? acc[r] * __expf(cs - pmt) : 0.f; rs += v[r]; }
#endif
                *(LAS u32x2*)(L + P4_S + (16 * mt + tl) * SP_ + (16 * st + 4 * gq) * 2) = (u32x2){pk2(v[0], v[1]), pk2(v[2], v[3])};
            }
            rs += __shfl_xor(rs, 16); rs += __shfl_xor(rs, 32);
            if (gq == 0) RS[(w & 1) * 64 + 16 * mt + tl] = rs;
            if (w & 1) {
                f32x4 acc = (f32x4){0.f, 0.f, 0.f, 0.f};
#pragma unroll
                for (int ds = 0; ds < 4; ++ds) { bf16x8 nf = *(const LAS bf16x8*)(NV + 32 * ds + 8 * gq);
                    if (tl != 0) nf = (bf16x8){0, 0, 0, 0, 0, 0, 0, 0};
                    acc = __builtin_amdgcn_mfma_f32_16x16x32_bf16(nf, frag_row(L + P4_Q, TP, 16 * mt + tl, 32 * ds + 8 * gq), acc, 0, 0, 0); }
                if (gq == 0) QN[16 * mt + tl] = acc[0];
            }
        }
        __syncthreads();
        float hv[4][4];
        {
            bf16x8 Cf[4];
#pragma unroll
            for (int ds = 0; ds < 4; ++ds) { const f32x4 lo = Ct[2 * ds], hi = Ct[2 * ds + 1];
                u32x4 p; p.x = pk2(lo[0], lo[1]); p.y = pk2(lo[2], lo[3]); p.z = pk2(hi[0], hi[1]); p.w = pk2(hi[2], hi[3]); Cf[ds] = __builtin_bit_cast(bf16x8, p); }
#ifdef DIAG_P4_NOTR
            const bf16x8 V0 = frag_row(L + P4_V, TP, tl, 8 * gq), V1 = frag_row(L + P4_V, TP, 16 + tl, 8 * gq);
#else
            const bf16x8 V0 = frag_tr(L + P4_V, 0, w, lane), V1 = frag_tr(L + P4_V, 1, w, lane);
#endif
#pragma unroll
            for (int mt = 0; mt < 4; ++mt) { const int t = 16 * mt + tl;
                f32x4 acc = (f32x4){0.f, 0.f, 0.f, 0.f};
#pragma unroll
                for (int ds = 0; ds < 4; ++ds) {
                    const u32x2 q0 = *(const LAS u32x2*)(L + P4_Q + t * TP + (32 * ds + 4 * gq) * 2), q1 = *(const LAS u32x2*)(L + P4_Q + t * TP + (32 * ds + 16 + 4 * gq) * 2);
                    const u32x4 qq = {q0.x, q0.y, q1.x, q1.y};
                    acc = __builtin_amdgcn_mfma_f32_16x16x32_bf16(Cf[ds], __builtin_bit_cast(bf16x8, qq), acc, 0, 0, 0); }
                const float pmt = __shfl(G.pm, t), bt = __shfl(G.b, t);
                const float a_inter = __expf(m - pmt);
                acc = acc * a_inter;
                acc = __builtin_amdgcn_mfma_f32_16x16x32_bf16(V0, frag_row(L + P4_S, SP_, t, 8 * gq), acc, 0, 0, 0);
                acc = __builtin_amdgcn_mfma_f32_16x16x32_bf16(V1, frag_row(L + P4_S, SP_, t, 32 + 8 * gq), acc, 0, 0, 0);
                const float den = a_inter * QN[t] + RS[t] + RS[64 + t];
                const float dn = fmaxf(fabsf(den), __expf(-(bt + pmt)));
#ifdef DIAG_P4_NODEN
                const float rinv = (dn > 0.f) ? 1.f : 1.f;
#else
                const float rinv = 1.f / dn;
#endif
                float ssq = 0.f;
#pragma unroll
                for (int r = 0; r < 4; ++r) { hv[mt][r] = acc[r] * rinv; ssq += hv[mt][r] * hv[mt][r]; }
                ssq += __shfl_xor(ssq, 16); ssq += __shfl_xor(ssq, 32);
                if (gq == 0) SSQ[w * 64 + t] = ssq;
            }
        }
        __syncthreads();
        {
#pragma unroll
            for (int mt = 0; mt < 4; ++mt) { const int t = 16 * mt + tl;
                float ss = 0.f;
#pragma unroll
                for (int ww = 0; ww < 8; ++ww) ss += SSQ[ww * 64 + t];
                const float rn = rsqrtf(ss * (1.f / 128.f) + 1e-6f);
                const u32x2 ov = *(const LAS u32x2*)(L + P4_O + t * TP + (16 * w + 4 * gq) * 2), uv = *(const LAS u32x2*)(L + P4_UC + t * TP + (16 * w + 4 * gq) * 2);
                const float o4[4] = {__builtin_bit_cast(float, ov.x << 16), __builtin_bit_cast(float, ov.x & 0xffff0000u), __builtin_bit_cast(float, ov.y << 16), __builtin_bit_cast(float, ov.y & 0xffff0000u)};
                const float u4[4] = {__builtin_bit_cast(float, uv.x << 16), __builtin_bit_cast(float, uv.x & 0xffff0000u), __builtin_bit_cast(float, uv.y << 16), __builtin_bit_cast(float, uv.y & 0xffff0000u)};
                float y[4];
#pragma unroll
                for (int r = 0; r < 4; ++r) {
#ifdef DIAG_P4_QK
                    { const u32x2 qv_ = *(const LAS u32x2*)(L + P4_Q + t * TP + (16 * w + 4 * gq) * 2), kv_ = *(const LAS u32x2*)(L + P4_K + t * TP + (16 * w + 4 * gq) * 2);
                      const unsigned qq_ = (r < 2) ? qv_.x : qv_.y, kk_ = (r < 2) ? kv_.x : kv_.y;
                      const float qf_ = (r & 1) ? __builtin_bit_cast(float, qq_ & 0xffff0000u) : __builtin_bit_cast(float, qq_ << 16);
                      const float kf_ = (r & 1) ? __builtin_bit_cast(float, kk_ & 0xffff0000u) : __builtin_bit_cast(float, kk_ << 16);
                      y[r] = (1.f / (1.f + __expf(-o4[r]))) * (qf_ + kf_); }
#elif defined(DIAG_P4_NOH)
                    y[r] = (1.f / (1.f + __expf(-o4[r]))) * (sk[r] * u4[r]);
#elif defined(DIAG_P4_NORN)
                    y[r] = (1.f / (1.f + __expf(-o4[r]))) * (hv[mt][r] * ng[r] + sk[r] * u4[r]);
#else
                    y[r] = (1.f / (1.f + __expf(-o4[r]))) * (hv[mt][r] * rn * ng[r] + sk[r] * u4[r]);
#endif
                }
                *(LAS u32x2*)(L + P4_Y + t * TP + (16 * w + 4 * gq) * 2) = (u32x2){pk2(y[0], y[1]), pk2(y[2], y[3])}; }
#ifndef DIAG_P4_NO_UPDATE
            state_update(L + P4_K, L + P4_V, Ct, nacc, G, m, w, lane);
#endif
            m = G.b_last + G.pm_last;
            if (tl == 0) { *(LAS u32x2*)(NV + 16 * w + 4 * gq) = (u32x2){pk2(nacc[0], nacc[1]), pk2(nacc[2], nacc[3])}; }
        }
        __syncthreads();
        tile_store(F, L + P4_Y, yg + (size_t)tok * 1024 + h * 128, 1024);
    }
    __syncthreads();
}

__global__ void __launch_bounds__(NWAVES * 64, 2) mk_fwd(Args args) {
    extern __shared__ __attribute__((aligned(16))) unsigned char lds_raw[];
    Frame F;
    F.lds = (LAS unsigned char*)lds_raw;
    F.tid = threadIdx.x; F.lane = F.tid & 63; F.wave = __builtin_amdgcn_readfirstlane(F.tid >> 6); F.G = gridDim.x;
    F.in = args.in;
    F.out = args.out; F.ws = args.ws; F.ctl = (unsigned*)(args.ws + WS_CTL);
#ifdef PROJ_IN_OUT
    F.proj = (bf16*)args.out;
#else
    F.proj = (bf16*)(args.ws + WS_PROJ);
#endif
    volatile LAS unsigned* MISC = (volatile LAS unsigned*)(F.lds + MISC_OFF);
    if (F.tid < 64) MISC[F.tid] = 0u;
    __syncthreads();
    const int lo = args.ph_lo, hi = args.ph_hi;
    const bool multi = (hi - lo) > 1;
    XcdBarrier bar; bar.bar = F.ctl + CW_BAR; bar.x = 0; bar.st = nullptr;
    if (multi) bar = xcd_barrier_post(F.ctl + CW_BAR, MISC + 8);
#ifndef PH_MASK
#define PH_MASK 0xFFFF
#endif
#define IN(k) (((PH_MASK >> (k)) & 1) && lo <= (k) && (k) < hi)
#define BOTH(k) (IN(k) && IN((k) + 1))
    if (IN(0)) { p0_prologue(F); if (BOTH(0)) xcd_barrier(bar); }
    if (IN(1)) { p1_norm1(F); if (BOTH(1)) xcd_barrier(bar); }
    if (IN(2)) {
        pg8::DenseOrder S; S.init(F.ws + WS_ACT1, F.ws + WS_WIN, T_TOK, N_PROJ, 1024, F.G, (int)blockIdx.x);
        MkEpiBf16 E{F.proj, N_PROJ};
        pg8::gemm_phase<MkEpiBf16, pg8::DenseOrder, true>(F.lds, 1024, S, E);
        if (BOTH(2)) xcd_barrier(bar);
    }
    if (IN(3)) { for (int unit = blockIdx.x; unit < 256; unit += F.G) p3_unit(F, unit); if (BOTH(3)) xcd_barrier(bar); }
#ifdef DIAG_SKIP_P4
    if (IN(4)) { bf16* yg = (bf16*)(F.ws + WS_ACT1); for (int i = blockIdx.x * 512 + F.tid; i < T_TOK * 64; i += F.G * 512) { const int t = i >> 6, c = (i & 63) * 8; *(u32x4*)(yg + (size_t)t * 1024 + c) = (u32x4){0u, 0u, 0u, 0u}; } }
#else
    if (IN(4)) { for (int unit = blockIdx.x; unit < 256; unit += F.G) p4_unit(F, unit, (bf16*)(F.ws + WS_ACT1)); if (BOTH(4)) xcd_barrier(bar); }
#ifdef DIAG_P4_TWICE
    if (IN(10)) { for (int unit = blockIdx.x; unit < 256; unit += F.G) p4_unit(F, unit, (bf16*)(F.ws + 420 * MiB)); }
#endif
#endif
    if (IN(5)) {
        pg8::DenseOrder S; S.init(F.ws + WS_ACT1, F.ws + WS_WOUT, T_TOK, 1024, 1024, F.G, (int)blockIdx.x);
        MkEpiResid E{F.in[0], (const float*)(F.ws + WS_MOD), F.out};
        pg8::gemm_phase<MkEpiResid, pg8::DenseOrder, true>(F.lds, 1024, S, E);
        if (BOTH(5)) xcd_barrier(bar);
    }
    if (IN(6)) { for (int grp = blockIdx.x; grp < 256; grp += F.G) p6_router_group(F, grp); if (BOTH(6)) xcd_barrier(bar); }
    if (IN(7)) {
        moe_table(F);
        LAS int* ts = (LAS int*)(F.lds + MOE_OFF);
        MoeOrder S{(const char*)(F.ws + WS_ACT1), (const char*)(F.ws + WS_WGU), (const int*)(F.ws + WS_LIST), ts, ts + 33, 1024, (size_t)1024 * 1024 * 2, F.G, (int)blockIdx.x, true};
        MkEpiSwiglu E{(bf16*)(F.ws + WS_HID)};
        pg8::gemm_phase<MkEpiSwiglu, MoeOrder, true>(F.lds, 1024, S, E);
        if (BOTH(7)) xcd_barrier(bar);
    }
    if (IN(8)) {
        moe_table(F);
        LAS int* ts = (LAS int*)(F.lds + MOE_OFF);
        MoeOrder S{(const char*)(F.ws + WS_HID), (const char*)(F.ws + WS_WD), (const int*)(F.ws + WS_LIST), ts, ts + 33, 512, (size_t)1024 * 512 * 2, F.G, (int)blockIdx.x, false};
        MkEpiSlot E{(bf16*)(F.ws + WS_SLOT), (const int*)(F.ws + WS_LIST), (const float*)(F.ws + WS_ASGG)};
        pg8::gemm_phase<MkEpiSlot, MoeOrder, true>(F.lds, 512, S, E);
        if (BOTH(8)) xcd_barrier(bar);
    }
    if (IN(9)) { p9_final(F); }
#undef IN
#undef BOTH
}

__global__ void __launch_bounds__(256) k_glue_y(const float* proj, bf16* y) {
    const int t = blockIdx.x;
    for (int c = threadIdx.x; c < 1024; c += 256) { const float v = proj[(size_t)t * 2056 + c]; y[(size_t)t * 1024 + c] = (bf16)(pg8::cvt_pk_bf16(v, 0.f) & 0xffffu); }
}

__global__ void __launch_bounds__(256) k_glue_proj(const bf16* pb, const float* gif, float* proj) {
    const int t = blockIdx.x;
    for (int c = threadIdx.x; c < 2056; c += 256) {
        float v;
        if (c < 1536) v = bf2f(pb[(size_t)t * 2048 + c]);
        else if (c < 1544) v = gif[(size_t)t * 8 + (c - 1536)];
        else v = bf2f(pb[(size_t)t * 2048 + (c - 8)]);
        proj[(size_t)t * 2056 + c] = v;
    }
}

#ifdef DIAG_P4_TWICE
__global__ void k_diag_cmp(const unsigned* a, const unsigned* b, unsigned* flag) {
    const size_t i = (size_t)blockIdx.x * 256 + threadIdx.x;
    const size_t t = i >> 8, c = i & 255;
    if (a[t * 512 + c] != b[t * 512 + c]) atomicAdd(flag, 1u);
}
__global__ void k_diag_poison(float* out, const unsigned* flag) { if (*flag) out[threadIdx.x] = __builtin_nanf(""); }
#endif

extern "C" void kernel_launch(void* const* d_in, const int* in_sizes, int n_in, void* d_out, int out_size, void* d_ws, size_t ws_size, hipStream_t stream) {
    static int inited = 0;
    if (!inited) { (void)hipFuncSetAttribute((const void*)mk_fwd, hipFuncAttributeMaxDynamicSharedMemorySize, LDS_BYTES); inited = 1; }
    (void)hipMemsetAsync((char*)d_ws + WS_CTL, 0, CTL_ZERO_BYTES, stream);
    Args a{};
    for (int i = 0; i < 27; ++i) a.in[i] = (const float*)d_in[i];
    a.out = (float*)d_out; a.ws = (unsigned char*)d_ws;
    a.ph_lo = 0; a.ph_hi = 10;
    mk_fwd<<<256, 512, LDS_BYTES, stream>>>(a);
}
```

```cpp
#define HYB 0
#include <hip/hip_runtime.h>
#include <stdint.h>
#include <stdio.h>
namespace pg8 {
#define PG8_LAS __attribute__((address_space(3)))
typedef unsigned short bf16_t;
typedef short bf16x8 __attribute__((ext_vector_type(8)));
typedef float f32x4 __attribute__((ext_vector_type(4)));
typedef unsigned u32x4 __attribute__((ext_vector_type(4)));
constexpr int BM = 256, BK = 64, HALF = 128, HTB = HALF * BK * 2  , STAGE_BYTES = 8 * HTB, NXCD = 8, WGM = 8;

__host__ __device__ __forceinline__ int lds_byte(int r, int c) { const int st = (r >> 4) * 2 + (c >> 5), rr = r & 15, cc = c & 31, ob = rr * 64 + cc * 2; return st * 1024 + (ob ^ (((ob >> 9) & 1) << 5)); }
__host__ __device__ __forceinline__ void stage_rc(int b, int& R, int& C) { const int st = b / 1024, sb = b % 1024, swz = sb ^ (((sb >> 9) & 1) << 5); R = (st >> 1) * 16 + swz / 64; C = (st & 1) * 32 + (swz % 64) / 2; }
__host__ __device__ __forceinline__ int perm32(int rho) { const int n = rho >> 4, i = rho & 15; return 8 * (i >> 2) + 4 * n + (i & 3); }

struct Unit { const char* A; const char* B; int pm, pn, e, nvalid; };

typedef __bf16 bf16x2_t __attribute__((ext_vector_type(2)));
__device__ __forceinline__ unsigned cvt_pk_bf16(float lo, float hi) { bf16x2_t v; v[0] = (__bf16)lo; v[1] = (__bf16)hi; return __builtin_bit_cast(unsigned, v); }

struct DenseOrder {
    const char* A; const char* Bt; int K; int nM, nN, nwg, G, c;
    __device__ void init(const void* A_, const void* Bt_, int M, int N, int K_, int G_, int c_) { A = (const char*)A_; Bt = (const char*)Bt_; K = K_; nM = M / BM; nN = N / BM; nwg = nM * nN; G = G_; c = c_; }
    __device__ __forceinline__ bool next(int i, Unit& u) const {
        const long L = (long)i * G + c; if (L >= nwg) return false;
        int wgid = (int)L; { const int q = nwg / NXCD, r = nwg % NXCD, xcd = wgid % NXCD, off = wgid / NXCD; wgid = (xcd < r ? xcd * (q + 1) : r * (q + 1) + (xcd - r) * q) + off; }
        const int nig = WGM * nN, gid = wgid / nig, fm = gid * WGM, gsz = (nM - fm) < WGM ? (nM - fm) : WGM;
        u.pm = fm + ((wgid % nig) % gsz); u.pn = (wgid % nig) / gsz; u.e = 0; u.nvalid = 256;
        u.A = A + (size_t)u.pm * BM * K * 2; u.B = Bt + (size_t)u.pn * BM * K * 2; return true;
    }
    __device__ __forceinline__ unsigned a_row_off(const Unit&, int r) const { return (unsigned)(r * K * 2); }
    __device__ __forceinline__ void a_ready(const Unit&) const {}
    __device__ __forceinline__ void done(const Unit&) const {}
};

template <class Epi, class Sched, bool ALIGN_EPI>
__device__ __forceinline__ void gemm_phase(PG8_LAS unsigned char* lds, const int K, const Sched& S, const Epi& E) {
    const int tid = threadIdx.x, wid = __builtin_amdgcn_readfirstlane(tid >> 6), lane = tid & 63, wr = wid >> 2, wc = wid & 3, fr = lane & 15, fq = lane >> 4;
    const int nt = K / BK;
    int Rr[2], Cc2[2]; unsigned voffB[2];
#pragma unroll
    for (int i = 0; i < 2; ++i) { int R, C; stage_rc(tid * 16 + i * 8192, R, C); const int Rb = Epi::PERM ? ((R & ~31) + perm32(R & 31)) : R;
        Rr[i] = R; Cc2[i] = C * 2; voffB[i] = (unsigned)(Rb * K + C) * 2u; }
    const size_t kstep = (size_t)(BK * 2);
    const size_t hstep = (size_t)HALF * K * 2;
    const unsigned ldsw = (unsigned)wid * 1024u;
    const int aoff = lds_byte(wr * 64 + fr, fq * 8), boff = lds_byte(wc * 32 + fr, fq * 8);
#define PG8_SA(b, h) (((b) * 2 + (h)) * HTB)
#define PG8_SB(b, h) ((4 + (b) * 2 + (h)) * HTB)
#define PG8_STAGE(bufoff, gbase, voff) do { _Pragma("unroll") for (int _i = 0; _i < 2; ++_i) \
        __builtin_amdgcn_global_load_lds((const unsigned*)((const char*)(gbase) + (voff)[_i]), (PG8_LAS unsigned*)(lds + (bufoff) + ldsw + _i * 8192), 16, 0, 0); } while (0)
#define PG8_LDA(dst, b, h) do { _Pragma("unroll") for (int m = 0; m < 4; ++m) _Pragma("unroll") for (int k = 0; k < 2; ++k) dst[m][k] = *(const PG8_LAS bf16x8*)(lds + PG8_SA(b, h) + aoff + m * 2048 + k * 1024); } while (0)
#define PG8_LDB(dst, b, h) do { _Pragma("unroll") for (int n = 0; n < 2; ++n) _Pragma("unroll") for (int k = 0; k < 2; ++k) dst[n][k] = *(const PG8_LAS bf16x8*)(lds + PG8_SB(b, h) + boff + n * 2048 + k * 1024); } while (0)
#define PG8_MMA(ai, bj, At, Bt) do { __builtin_amdgcn_s_setprio(1); _Pragma("unroll") for (int m = 0; m < 4; ++m) _Pragma("unroll") for (int n = 0; n < 2; ++n) _Pragma("unroll") for (int k = 0; k < 2; ++k) \
        acc[ai][bj][m][n] = __builtin_amdgcn_mfma_f32_16x16x32_bf16(Bt[n][k], At[m][k], acc[ai][bj][m][n], 0, 0, 0); __builtin_amdgcn_s_setprio(0); } while (0)
#define PG8_WAIT_V(n) asm volatile("s_waitcnt vmcnt(" #n ")" ::: "memory")
#define PG8_WAIT_L(n) asm volatile("s_waitcnt lgkmcnt(" #n ")" ::: "memory")
#define PG8_BAR __builtin_amdgcn_s_barrier()
#define PG8_SCHED __builtin_amdgcn_sched_barrier(0)
#define PG8_LOADVA(dst, u) do { _Pragma("unroll") for (int _h = 0; _h < 2; ++_h) _Pragma("unroll") for (int _i = 0; _i < 2; ++_i) dst[_h][_i] = S.a_row_off(u, _h * HALF + Rr[_i]) + (unsigned)Cc2[_i]; } while (0)
    Unit cur, nxt; int ui = 0;
    if (!S.next(0, cur)) return;
    f32x4 acc[2][2][4][2];
#pragma unroll
    for (int a = 0; a < 2; ++a)
#pragma unroll
        for (int b = 0; b < 2; ++b)
#pragma unroll
            for (int m = 0; m < 4; ++m)
#pragma unroll
                for (int n = 0; n < 2; ++n) acc[a][b][m][n] = (f32x4){0.f, 0.f, 0.f, 0.f};
    bf16x8 At[4][2], B0[2][2], B1[2][2];
    unsigned vA[2][2], vN[2][2];
    const char* cA = cur.A; const char* cB = cur.B;
    S.a_ready(cur);
    PG8_LOADVA(vA, cur);
    PG8_STAGE(PG8_SB(0, 0), cB, voffB); PG8_STAGE(PG8_SB(0, 1), cB + hstep, voffB); PG8_STAGE(PG8_SA(0, 0), cA, vA[0]); PG8_STAGE(PG8_SA(0, 1), cA, vA[1]);
    if (wr == 1) PG8_BAR;
    PG8_WAIT_V(2); PG8_BAR;
    PG8_STAGE(PG8_SB(1, 0), cB + kstep, voffB); PG8_STAGE(PG8_SA(1, 0), cA + kstep, vA[0]); PG8_STAGE(PG8_SB(1, 1), cB + hstep + kstep, voffB);
    PG8_WAIT_V(6); PG8_BAR;
    for (;;) {
        const bool has_next = S.next(ui + 1, nxt);
        const char* nA = has_next ? nxt.A : cA; const char* nB = has_next ? nxt.B : cB;
        for (int t = 0; t < nt; t += 2) {
            const bool last = (t == nt - 2);
            if (last) { if (has_next) { S.a_ready(nxt); PG8_LOADVA(vN, nxt); } else {
#pragma unroll
                for (int _h = 0; _h < 2; ++_h)
#pragma unroll
                    for (int _i = 0; _i < 2; ++_i) vN[_h][_i] = vA[_h][_i]; } }
            const char* a1 = cA + (size_t)(t + 1) * kstep;
            const char* a2 = last ? nA : cA + (size_t)(t + 2) * kstep; const char* b2 = last ? nB : cB + (size_t)(t + 2) * kstep;
            const char* a3 = a2 + kstep; const char* b3 = b2 + kstep;
            unsigned o0[2], o1[2];
#pragma unroll
            for (int _i = 0; _i < 2; ++_i) { o0[_i] = last ? vN[0][_i] : vA[0][_i]; o1[_i] = last ? vN[1][_i] : vA[1][_i]; }
            PG8_LDB(B0, 0, 0); PG8_LDB(B1, 0, 1); PG8_SCHED; PG8_LDA(At, 0, 0); PG8_STAGE(PG8_SA(1, 1), a1, vA[1]);
            PG8_WAIT_V(8); PG8_WAIT_L(0); PG8_BAR; PG8_MMA(0, 0, At, B0); PG8_MMA(0, 1, At, B1); PG8_BAR; PG8_SCHED;
            PG8_LDA(At, 0, 1); PG8_STAGE(PG8_SB(0, 0), b2, voffB); PG8_STAGE(PG8_SB(0, 1), b2 + hstep, voffB); PG8_STAGE(PG8_SA(0, 0), a2, o0);
            PG8_WAIT_V(8); PG8_WAIT_L(0); PG8_BAR; PG8_MMA(1, 0, At, B0); PG8_MMA(1, 1, At, B1); PG8_BAR; PG8_SCHED;
            PG8_LDB(B0, 1, 0); PG8_LDB(B1, 1, 1); PG8_SCHED; PG8_LDA(At, 1, 0); PG8_STAGE(PG8_SA(0, 1), a2, o1);
            PG8_WAIT_V(8); PG8_WAIT_L(0); PG8_BAR; PG8_MMA(0, 0, At, B0); PG8_MMA(0, 1, At, B1); PG8_BAR; PG8_SCHED;
            PG8_LDA(At, 1, 1); PG8_STAGE(PG8_SB(1, 0), b3, voffB); PG8_STAGE(PG8_SB(1, 1), b3 + hstep, voffB); PG8_STAGE(PG8_SA(1, 0), a3, o0);
            PG8_WAIT_V(8); PG8_WAIT_L(0); PG8_BAR; PG8_MMA(1, 0, At, B0); PG8_MMA(1, 1, At, B1); PG8_BAR; PG8_SCHED;
        }
        if constexpr (ALIGN_EPI) { if (wr == 0) PG8_BAR; }
        E(acc, cur, wr, wc, fr, fq); S.done(cur);
        if (!has_next) break;
#pragma unroll
        for (int a = 0; a < 2; ++a)
#pragma unroll
            for (int b = 0; b < 2; ++b)
#pragma unroll
                for (int m = 0; m < 4; ++m)
#pragma unroll
                    for (int n = 0; n < 2; ++n) acc[a][b][m][n] = (f32x4){0.f, 0.f, 0.f, 0.f};
        cur = nxt; cA = nA; cB = nB; ++ui;
#pragma unroll
        for (int _h = 0; _h < 2; ++_h)
#pragma unroll
            for (int _i = 0; _i < 2; ++_i) vA[_h][_i] = vN[_h][_i];
        if constexpr (ALIGN_EPI) { if (wr == 1) PG8_BAR; }
    }
    PG8_WAIT_V(0);
    if constexpr (!ALIGN_EPI) { if (wr == 0) PG8_BAR; }
    PG8_BAR;
#undef PG8_SA
#undef PG8_SB
#undef PG8_STAGE
#undef PG8_LDA
#undef PG8_LDB
#undef PG8_MMA
#undef PG8_WAIT_V
#undef PG8_WAIT_L
#undef PG8_BAR
#undef PG8_SCHED
#undef PG8_LOADVA
}
}

constexpr int T_TOK = 32768, D_M = 1024, N_PROJ = 2048, NWAVES = 8;
constexpr size_t MiB = 1u << 20;
constexpr size_t WS_CTL = 0, CTL_ZERO_BYTES = 1 * MiB;
constexpr size_t WS_MOD = 1 * MiB;
constexpr size_t WS_RC = 1 * MiB + 256 * 1024;
constexpr size_t WS_GIF = 2 * MiB;
constexpr size_t WS_ASGE = 3 * MiB;
constexpr size_t WS_ASGG = 3 * MiB + 256 * 1024;
constexpr size_t WS_LIST = 4 * MiB;
constexpr size_t WS_WIN = 8 * MiB;
constexpr size_t WS_WQ = 12 * MiB, WS_WK = WS_WQ + 128 * 1024, WS_WPOOL = WS_WK + 128 * 1024;
constexpr size_t WS_WOUT = 12 * MiB + 512 * 1024;
constexpr size_t WS_WR = 14 * MiB + 512 * 1024;
constexpr size_t WS_WGU = 16 * MiB;
constexpr size_t WS_WD = 80 * MiB;
#if defined(HYB) && HYB == 1
constexpr size_t WS_ACT1 = 16 * MiB, WS_PROJ = 80 * MiB;
#define CVT_LIMIT 216
#elif defined(HYB) && HYB == 2
constexpr size_t WS_ACT1 = 112 * MiB, WS_PROJ = 0;
#define CVT_LIMIT CVT_NTILES
#define PROJ_IN_OUT 1
#else
constexpr size_t WS_ACT1 = 112 * MiB;
constexpr size_t WS_PROJ = 176 * MiB;
#define CVT_LIMIT CVT_NTILES
#endif
constexpr size_t WS_HID = 176 * MiB;
constexpr size_t WS_SLOT = 248 * MiB;
constexpr size_t WS_MIXG = 376 * MiB;
constexpr size_t WS_X1B = 440 * MiB;
constexpr int CAPX = 32768;
constexpr int CW_TMO = 0;
constexpr int CW_BAR = 4096;
constexpr int CW_CNT = 16384;

constexpr int RING_BYTES = 131072;
constexpr int MISC_OFF = RING_BYTES;
constexpr int MOE_OFF = RING_BYTES + 256;
constexpr int LDS_BYTES = 163840;

#define GAS __attribute__((address_space(1)))
#define LAS __attribute__((address_space(3)))
typedef unsigned short bf16;
typedef float f32x4 __attribute__((ext_vector_type(4)));
typedef unsigned u32x4 __attribute__((ext_vector_type(4)));
typedef GAS unsigned gu32;
#define RLX_AGENT __ATOMIC_RELAXED, __HIP_MEMORY_SCOPE_AGENT
#define VM_WAIT() asm volatile("s_waitcnt vmcnt(0)" ::: "memory")

#define XB_TMO      128
#define XB_XCNT(j)  (256  + 64 * (j))
#define XB_XSUB(j)  (1280 + 64 * (j))
#define XB_XGEN(j)  (2304 + 64 * (j))
#define XB_TOP      3328
#define XB_TOPGEN   3392
#define XCD_BAR_WORDS 3456
#define XB_SPIN_CAP (1u << 18)
__device__ __forceinline__ unsigned xb_ld(unsigned* p)              { return __hip_atomic_load(p, __ATOMIC_RELAXED, __HIP_MEMORY_SCOPE_AGENT); }
__device__ __forceinline__ unsigned xb_add(unsigned* p, unsigned v) { return __hip_atomic_fetch_add(p, v, __ATOMIC_RELAXED, __HIP_MEMORY_SCOPE_AGENT); }
__device__ __forceinline__ unsigned xb_xcc_id() { return (unsigned)__builtin_amdgcn_s_getreg((3 << 11) | 20) & 0xFu; }
#define XB_SPIN(cond, bar) do { unsigned _sp = 0; while (cond) { __builtin_amdgcn_s_sleep(1); \
    if ((++_sp & 255u) == 0u) { if (xb_ld(&(bar)[XB_TMO])) break; if (_sp > XB_SPIN_CAP) { atomicAdd(&(bar)[XB_TMO], 1u); break; } } } } while (0)
struct XcdBarrier { unsigned* bar; unsigned x; volatile LAS unsigned* st; };
__device__ __forceinline__ XcdBarrier xcd_barrier_post(unsigned* bar, volatile LAS unsigned* st) {
    XcdBarrier b; b.bar = bar; b.x = xb_xcc_id(); b.st = st;
    if (threadIdx.x == 0) (void)xb_add(&bar[XB_XCNT(b.x)], 1u);
    return b;
}
__device__ __forceinline__ void xcd_barrier_complete(unsigned* bar, unsigned x, unsigned& nloc, unsigned& nx) {
    const unsigned G = gridDim.x * gridDim.y * gridDim.z;
    unsigned sum, cnt, mine, sp = 0u;
    for (;;) {
        sum = 0u; cnt = 0u; mine = 0u;
#pragma unroll
        for (unsigned j = 0; j < 16; ++j) { const unsigned c = xb_ld(&bar[XB_XCNT(j)]); sum += c; cnt += (c > 0u) ? 1u : 0u; mine = (j == x) ? c : mine; }
        if (sum == G) break;
        __builtin_amdgcn_s_sleep(1);
        if ((++sp & 255u) == 0u) { if (xb_ld(&bar[XB_TMO])) break; if (sp > XB_SPIN_CAP) { atomicAdd(&bar[XB_TMO], 1u); break; } }
    }
    nloc = mine > 0u ? mine : 1u; nx = cnt > 0u ? cnt : 1u;
}
__device__ __forceinline__ void xcd_barrier(const XcdBarrier& b) {
    asm volatile("s_waitcnt vmcnt(0)" ::: "memory");
    __syncthreads();
    if (threadIdx.x == 0) {
        unsigned* bar = b.bar;
        __builtin_amdgcn_s_waitcnt(0);
        unsigned nloc = b.st[0], nx = b.st[1];
        if (nloc == 0u) { xcd_barrier_complete(bar, b.x, nloc, nx); b.st[0] = nloc; b.st[1] = nx; }
        const unsigned old = xb_add(&bar[XB_XSUB(b.x)], 1u);
        const unsigned gen = old / nloc;
        if (old + 1u == (gen + 1u) * nloc) {
            __builtin_amdgcn_fence(__ATOMIC_RELEASE, "agent");
            asm volatile("s_waitcnt vmcnt(0)" ::: "memory");
            const unsigned og = xb_add(&bar[XB_TOP], 1u);
            const unsigned tg = og / nx;
            if (og + 1u == (tg + 1u) * nx) xb_add(&bar[XB_TOPGEN], 1u);
            else XB_SPIN(xb_ld(&bar[XB_TOPGEN]) == tg, bar);
            __builtin_amdgcn_fence(__ATOMIC_ACQUIRE, "agent");
            xb_add(&bar[XB_XGEN(b.x)], 1u);
            asm volatile("s_waitcnt vmcnt(0)" ::: "memory");
        } else {
            XB_SPIN(xb_ld(&bar[XB_XGEN(b.x)]) == gen, bar);
            __builtin_amdgcn_fence(__ATOMIC_ACQUIRE, "agent");
            asm volatile("s_waitcnt vmcnt(0)" ::: "memory");
        }
    }
    __syncthreads();
}

struct Args { const float* in[27]; float* out; unsigned char* ws; int ph_lo, ph_hi; };
struct Frame {
    LAS unsigned char* lds; int tid, lane, wave, G;
    const float* const* in; float* out; unsigned char* ws; unsigned* ctl; bf16* proj;
};
__device__ __forceinline__ unsigned pk2(float lo, float hi) { return pg8::cvt_pk_bf16(lo, hi); }
__device__ __forceinline__ float bf2f(unsigned short v) { return __builtin_bit_cast(float, (unsigned)v << 16); }
__device__ __forceinline__ float wave_sum(float v) {
#pragma unroll
    for (int o = 32; o > 0; o >>= 1) v += __shfl_xor(v, o);
    return v;
}
__device__ __forceinline__ float silu_f(float a) { return a / (1.f + __expf(-a)); }

constexpr int CVT_NTILES = 128 + 24 + 64 + 1024 + 1024 + 1024;
__device__ __forceinline__ void p0_cvt_tile(const Frame& F, int id) {
    const float* src; int ld_src; bf16* dst; int ld_dst; int width = 256; int mode = 0; int n0 = 0; int add = 0; int k0;
    unsigned char* ws = F.ws;
    if (id < 128) {
        const int kt = id >> 3, nt = id & 7; k0 = kt * 64; n0 = nt * 256;
        const int sc = (nt < 6) ? n0 : n0 + 8;
        src = F.in[5] + (size_t)k0 * 2056 + sc; ld_src = 2056; dst = (bf16*)(ws + WS_WIN); ld_dst = 1024;
    } else if (id < 152) {
        const int j = id - 128, which = j >> 3, hh = (j >> 1) & 3, kt = j & 1; k0 = kt * 64; width = 128;
        src = (which == 0 ? F.in[8] : (which == 1 ? F.in[9] : F.in[14])) + (size_t)hh * 16384 + (size_t)k0 * 128; ld_src = 128;
        dst = (bf16*)(ws + (which == 0 ? WS_WQ : (which == 1 ? WS_WK : WS_WPOOL))) + (size_t)hh * 16384; ld_dst = 128;
    } else if (id < 216) {
        const int j = id - 152, kt = j >> 2, nt = j & 3; k0 = kt * 64; n0 = nt * 256;
        src = F.in[17] + (size_t)k0 * 1024 + n0; ld_src = 1024; dst = (bf16*)(ws + WS_WOUT); ld_dst = 1024;
    } else if (id < 216 + 2048) {
        int j = id - 216; const int up = j >= 1024; j &= 1023; const int e = j >> 5, kt = (j >> 1) & 15, nt = j & 1; k0 = kt * 64; n0 = nt * 256;
        src = (up ? F.in[24] : F.in[23]) + (size_t)e * 1024 * 512 + (size_t)k0 * 512 + n0; ld_src = 512;
        dst = (bf16*)(ws + WS_WGU) + (size_t)e * 1024 * 1024; ld_dst = 1024; mode = 1; add = up ? 128 : 0;
    } else {
        const int j = id - 216 - 2048, e = j >> 5, kt = (j >> 2) & 7, nt = j & 3; k0 = kt * 64; n0 = nt * 256;
        src = F.in[25] + (size_t)e * 512 * 1024 + (size_t)k0 * 1024 + n0; ld_src = 1024;
        dst = (bf16*)(ws + WS_WD) + (size_t)e * 1024 * 512; ld_dst = 512;
    }
    LAS float* tl = (LAS float*)F.lds;
    const int pitch = width + 1;
    const int f4_per_row = width >> 2;
    const int nload = (64 * f4_per_row) / 512;
    f32x4 v[8];
#pragma unroll
    for (int p = 0; p < 8; ++p) if (p < nload) { const int idx = F.tid + p * 512, row = idx / f4_per_row, c4 = idx % f4_per_row;
        v[p] = *(const f32x4*)(src + (size_t)row * ld_src + 4 * c4); }
#pragma unroll
    for (int p = 0; p < 8; ++p) if (p < nload) { const int idx = F.tid + p * 512, row = idx / f4_per_row, c4 = idx % f4_per_row;
        tl[row * pitch + 4 * c4 + 0] = v[p][0]; tl[row * pitch + 4 * c4 + 1] = v[p][1]; tl[row * pitch + 4 * c4 + 2] = v[p][2]; tl[row * pitch + 4 * c4 + 3] = v[p][3]; }
    __syncthreads();
    const int nitems = width * 8 / 512;
#pragma unroll
    for (int p = 0; p < 4; ++p) if (p < nitems) { const int idx = F.tid + p * 512, n = idx >> 3, ks = idx & 7;
        float a[8];
#pragma unroll
        for (int j = 0; j < 8; ++j) a[j] = tl[(8 * ks + j) * pitch + n];
        u32x4 w; w.x = pk2(a[0], a[1]); w.y = pk2(a[2], a[3]); w.z = pk2(a[4], a[5]); w.w = pk2(a[6], a[7]);
        const int ng = n0 + n;
        const int drow = (mode == 1) ? (256 * (ng >> 7) + (ng & 127) + add) : ng;
        *(u32x4*)(dst + (size_t)drow * ld_dst + k0 + 8 * ks) = w; }
    __syncthreads();
}

__device__ __forceinline__ void p0_mod(const Frame& F, int cg) {
    LAS float* sc = (LAS float*)F.lds;
    LAS float* red = (LAS float*)(F.lds + 32768);
    const float* c = F.in[1]; const float* ada_w = F.in[2]; const float* ada_b = F.in[3];
    float* mod = (float*)(F.ws + WS_MOD);
    for (int i = F.tid; i < 8192; i += 512) sc[i] = silu_f(c[i]);
    __syncthreads();
    const int g = F.tid % 6, kl = F.tid / 6;
    if (kl < 85) {
        f32x4 acc[8];
#pragma unroll
        for (int b = 0; b < 8; ++b) acc[b] = (f32x4){0.f, 0.f, 0.f, 0.f};
        for (int k = kl; k < 1024; k += 85) {
            const f32x4 w = *(const f32x4*)(ada_w + (size_t)k * 6144 + 24 * cg + 4 * g);
#pragma unroll
            for (int b = 0; b < 8; ++b) acc[b] += w * sc[b * 1024 + k];
        }
#pragma unroll
        for (int b = 0; b < 8; ++b)
#pragma unroll
            for (int j = 0; j < 4; ++j) red[(kl * 6 + g) * 32 + b * 4 + j] = acc[b][j];
    }
    __syncthreads();
    if (F.tid < 192) {
        const int gg = F.tid >> 5, bj = F.tid & 31, b = bj >> 2, j = bj & 3;
        float s = 0.f;
        for (int k = 0; k < 85; ++k) s += red[(k * 6 + gg) * 32 + bj];
        const int col = 24 * cg + 4 * gg + j;
        mod[b * 6144 + col] = s + ada_b[col];
    }
    __syncthreads();
}

__device__ __forceinline__ void p0_prologue(const Frame& F) {
    for (int id = blockIdx.x; id < CVT_LIMIT; id += F.G) p0_cvt_tile(F, id);
    for (int cg = blockIdx.x; cg < 256; cg += F.G) p0_mod(F, cg);
}

__device__ __forceinline__ void split_hi_lo(const float (&a)[8], u32x4& hi, u32x4& lo) {
    unsigned h[4], l[4];
#pragma unroll
    for (int j = 0; j < 4; ++j) { h[j] = pk2(a[2 * j], a[2 * j + 1]);
        const float r0 = a[2 * j] - __builtin_bit_cast(float, h[j] << 16), r1 = a[2 * j + 1] - __builtin_bit_cast(float, h[j] & 0xffff0000u);
        l[j] = pk2(r0, r1); }
    hi = (u32x4){h[0], h[1], h[2], h[3]}; lo = (u32x4){l[0], l[1], l[2], l[3]};
}
__device__ __forceinline__ void p1_router_weights(const Frame& F) {
    const float* g2 = F.in[18]; const float* w_rg = F.in[19]; const float* w_re = F.in[21]; const float* mod = (const float*)(F.ws + WS_MOD);
    u32x4* wr = (u32x4*)(F.ws + WS_WR);
    for (int item = blockIdx.x * 512 + F.tid; item < 8 * 8 * 3 * 4 * 64; item += F.G * 512) {
        const int lane = item & 63, s = (item >> 6) & 3, nt = (item >> 8) % 3, w = ((item >> 8) / 3) & 7, b = (item >> 8) / 24;
        const int tl = lane & 15, g = lane >> 4, c = 16 * nt + tl;
        float a[8];
#pragma unroll
        for (int j = 0; j < 8; ++j) { const int k = 128 * w + 32 * s + 8 * g + j;
            const float wv = (c < 4) ? w_rg[k * 4 + c] : (c < 36 ? w_re[k * 32 + (c - 4)] : 0.f);
            a[j] = g2[k] * (1.f + mod[b * 6144 + 4 * 1024 + k]) * wv; }
        u32x4 hi, lo; split_hi_lo(a, hi, lo);
        const size_t base = ((((size_t)b * 8 + w) * 3 + nt) * 4 + s) * 2;
        wr[(base + 0) * 64 + lane] = hi; wr[(base + 1) * 64 + lane] = lo;
    }
}
__device__ __forceinline__ void p1_router_consts(const Frame& F) {
    const float* w_rg = F.in[19]; const float* b_rg = F.in[20]; const float* w_re = F.in[21]; const float* b_re = F.in[22]; const float* mod = (const float*)(F.ws + WS_MOD);
    float* rc = (float*)(F.ws + WS_RC);
    for (int item = blockIdx.x * 8 + F.wave; item < 8 * 48; item += F.G * 8) {
        const int b = item / 48, c = item - b * 48;
        float s = 0.f;
        if (c < 36) {
#pragma unroll
            for (int j = 0; j < 16; ++j) { const int k = F.lane + 64 * j; s += mod[b * 6144 + 3 * 1024 + k] * (c < 4 ? w_rg[k * 4 + c] : w_re[k * 32 + (c - 4)]); }
        }
        s = wave_sum(s);
        if (F.lane == 0) rc[item] = (c < 36) ? s + (c < 4 ? b_rg[c] : b_re[c - 4]) : 0.f;
    }
}
__device__ __forceinline__ void p1_norm1(const Frame& F) {
    p1_router_weights(F);
    p1_router_consts(F);
    const float* x = F.in[0]; const float* g1 = F.in[4]; const float* w_in = F.in[5];
    const float* mod = (const float*)(F.ws + WS_MOD);
    bf16* h = (bf16*)(F.ws + WS_ACT1); float* gif = (float*)(F.ws + WS_GIF);
    const int lane = F.lane;
    float wg[16][8];
#pragma unroll
    for (int i = 0; i < 16; ++i) { const int k = (i < 8 ? 0 : 512) + 8 * lane + (i & 7);
        const f32x4 a = *(const f32x4*)(w_in + (size_t)k * 2056 + 1536), b = *(const f32x4*)(w_in + (size_t)k * 2056 + 1540);
        wg[i][0] = a[0]; wg[i][1] = a[1]; wg[i][2] = a[2]; wg[i][3] = a[3]; wg[i][4] = b[0]; wg[i][5] = b[1]; wg[i][6] = b[2]; wg[i][7] = b[3]; }
    float gg[16];
#pragma unroll
    for (int q = 0; q < 4; ++q) { const f32x4 t = *(const f32x4*)(g1 + (q >> 1) * 512 + 8 * lane + (q & 1) * 4); gg[4 * q] = t[0]; gg[4 * q + 1] = t[1]; gg[4 * q + 2] = t[2]; gg[4 * q + 3] = t[3]; }
    for (int row = blockIdx.x * 8 + F.wave; row < T_TOK; row += F.G * 8) {
        const int b = row >> 12;
        float hv[16];
#pragma unroll
        for (int q = 0; q < 4; ++q) { const int off = (q >> 1) * 512 + 8 * lane + (q & 1) * 4;
            const f32x4 t = *(const f32x4*)(x + (size_t)row * 1024 + off);
#pragma unroll
            for (int j = 0; j < 4; ++j) hv[4 * q + j] = t[j]; }
        float ss = 0.f;
#pragma unroll
        for (int i = 0; i < 16; ++i) ss += hv[i] * hv[i];
        ss = wave_sum(ss);
        const float r = rsqrtf(ss * (1.f / 1024.f) + 1e-6f);
#pragma unroll
        for (int q = 0; q < 4; ++q) { const int off = (q >> 1) * 512 + 8 * lane + (q & 1) * 4;
            const f32x4 s = *(const f32x4*)(mod + b * 6144 + 1024 + off), sh = *(const f32x4*)(mod + b * 6144 + off);
#pragma unroll
            for (int j = 0; j < 4; ++j) hv[4 * q + j] = hv[4 * q + j] * r * gg[4 * q + j] * (1.f + s[j]) + sh[j]; }
        u32x4 w0, w1;
        w0.x = pk2(hv[0], hv[1]); w0.y = pk2(hv[2], hv[3]); w0.z = pk2(hv[4], hv[5]); w0.w = pk2(hv[6], hv[7]);
        w1.x = pk2(hv[8], hv[9]); w1.y = pk2(hv[10], hv[11]); w1.z = pk2(hv[12], hv[13]); w1.w = pk2(hv[14], hv[15]);
        *(u32x4*)(h + (size_t)row * 1024 + 8 * lane) = w0;
        *(u32x4*)(h + (size_t)row * 1024 + 512 + 8 * lane) = w1;
        float ga[8];
#pragma unroll
        for (int j = 0; j < 8; ++j) { float a = 0.f;
#pragma unroll
            for (int i = 0; i < 16; ++i) a += hv[i] * wg[i][j];
            ga[j] = wave_sum(a); }
        if (lane == 0) { *(f32x4*)(gif + (size_t)row * 8) = (f32x4){ga[0], ga[1], ga[2], ga[3]}; *(f32x4*)(gif + (size_t)row * 8 + 4) = (f32x4){ga[4], ga[5], ga[6], ga[7]}; }
    }
}

struct MkEpiBf16 {
    static constexpr bool PERM = true;
    bf16* O; int ldc;
    __device__ __forceinline__ void operator()(const f32x4 (&acc)[2][2][4][2], const pg8::Unit& u, int wr, int wc, int fr, int fq) const {
        const int row0 = u.pm * 256 + wr * 64 + fr, col0 = u.pn * 256 + wc * 32 + 8 * fq;
#pragma unroll
        for (int ai = 0; ai < 2; ++ai)
#pragma unroll
            for (int m = 0; m < 4; ++m) { bf16* rowp = O + (size_t)(row0 + ai * 128 + m * 16) * ldc + col0;
#pragma unroll
                for (int bj = 0; bj < 2; ++bj) { const f32x4 v0 = acc[ai][bj][m][0], v1 = acc[ai][bj][m][1];
                    u32x4 w; w.x = pk2(v0[0], v0[1]); w.y = pk2(v0[2], v0[3]); w.z = pk2(v1[0], v1[1]); w.w = pk2(v1[2], v1[3]);
                    *(u32x4*)(rowp + bj * 128) = w; } }
    }
};


struct MkEpiMix {
    static constexpr bool PERM = true;
    const float* mod; bf16* O;
    __device__ __forceinline__ void operator()(const f32x4 (&acc)[2][2][4][2], const pg8::Unit& u, int wr, int wc, int fr, int fq) const {
        const int row0 = u.pm * 256 + wr * 64 + fr, col0 = u.pn * 256 + wc * 32 + 8 * fq;
        const float* ga = mod + (u.pm >> 4) * 6144 + 2 * 1024 + col0;
        f32x4 gv[2][2];
#pragma unroll
        for (int bj = 0; bj < 2; ++bj)
#pragma unroll
            for (int n = 0; n < 2; ++n) gv[bj][n] = *(const f32x4*)(ga + bj * 128 + n * 4);
#pragma unroll
        for (int ai = 0; ai < 2; ++ai)
#pragma unroll
            for (int m = 0; m < 4; ++m) { bf16* rowp = O + (size_t)(row0 + ai * 128 + m * 16) * 1024 + col0;
#pragma unroll
                for (int bj = 0; bj < 2; ++bj) { const f32x4 v0 = acc[ai][bj][m][0] * gv[bj][0], v1 = acc[ai][bj][m][1] * gv[bj][1];
                    u32x4 w; w.x = pk2(v0[0], v0[1]); w.y = pk2(v0[2], v0[3]); w.z = pk2(v1[0], v1[1]); w.w = pk2(v1[2], v1[3]);
                    *(u32x4*)(rowp + bj * 128) = w; } }
    }
};

typedef short bf16x8 __attribute__((ext_vector_type(8)));
constexpr int P6_XT = 0, P6_GP = 65792, P6_SH = 69888, P6_PART = 73984, P6_SSP = 98560, P6_LOG = 99072, P6_CONST = 102144, P6_RINV = 102336,
              P6_LCNT = 102400, P6_LBASE = 102528, P6_APOS = 102656, P6_AEXP = 103680;
__device__ __forceinline__ void p6_router_group(const Frame& F, int grp) {
    const float* xin = F.in[0]; const bf16* mixg = (const bf16*)(F.ws + WS_MIXG); bf16* x1b = (bf16*)(F.ws + WS_X1B); const float* g2 = F.in[18]; const float* w_rg = F.in[19]; const float* b_rg = F.in[20]; const float* w_re = F.in[21]; const float* b_re = F.in[22];
    const float* mod = (const float*)(F.ws + WS_MOD);
    bf16* h2 = (bf16*)(F.ws + WS_ACT1);
    float* asg_gate = (float*)(F.ws + WS_ASGG); int* list = (int*)(F.ws + WS_LIST); unsigned* cnt = F.ctl + CW_CNT;
    LAS float* XT = (LAS float*)(F.lds + P6_XT); LAS float* GP = (LAS float*)(F.lds + P6_GP); LAS float* SH = (LAS float*)(F.lds + P6_SH);
    LAS float* PART = (LAS float*)(F.lds + P6_PART); LAS float* SSP = (LAS float*)(F.lds + P6_SSP); LAS float* LOG = (LAS float*)(F.lds + P6_LOG);
    LAS float* CONST = (LAS float*)(F.lds + P6_CONST); LAS float* RINV = (LAS float*)(F.lds + P6_RINV);
    LAS int* LCNT = (LAS int*)(F.lds + P6_LCNT); LAS int* LBASE = (LAS int*)(F.lds + P6_LBASE); LAS int* APOS = (LAS int*)(F.lds + P6_APOS); LAS int* AEXP = (LAS int*)(F.lds + P6_AEXP);
    const int tid = F.tid, lane = F.lane, w = F.wave, tok0 = grp * 128, b = tok0 >> 12;
    const int tl = lane & 15, g = lane >> 4;
    for (int k = tid; k < 1024; k += 512) { GP[k] = g2[k] * (1.f + mod[b * 6144 + 4 * 1024 + k]); SH[k] = mod[b * 6144 + 3 * 1024 + k]; }
    if (tid < 32) LCNT[tid] = 0;
    if (tid < 48) CONST[tid] = ((const float*)(F.ws + WS_RC))[b * 48 + tid];
    __syncthreads();
    bf16x8 Bhi[3][4], Blo[3][4];
    { const u32x4* wr = (const u32x4*)(F.ws + WS_WR) + ((size_t)b * 8 + w) * 3 * 4 * 2 * 64 + lane;
#pragma unroll
      for (int nt = 0; nt < 3; ++nt)
#pragma unroll
        for (int s = 0; s < 4; ++s) { Bhi[nt][s] = __builtin_bit_cast(bf16x8, wr[((nt * 4 + s) * 2 + 0) * 64]); Blo[nt][s] = __builtin_bit_cast(bf16x8, wr[((nt * 4 + s) * 2 + 1) * 64]); } }
    f32x4 ld[8]; u32x4 lm[4];
#define P6_FETCH(tk) do { _Pragma("unroll") for (int p = 0; p < 4; ++p) { const int idx = tid + 512 * p, row = idx >> 7, c8 = idx & 127; const size_t o = (size_t)((tk) + row) * 1024 + 8 * c8; \
        ld[2 * p] = *(const f32x4*)(xin + o); ld[2 * p + 1] = *(const f32x4*)(xin + o + 4); lm[p] = *(const u32x4*)(mixg + o); } } while (0)
    P6_FETCH(tok0);
    for (int it = 0; it < 8; ++it) {
        const int tok = tok0 + 16 * it;
#pragma unroll
        for (int p = 0; p < 4; ++p) { const int idx = tid + 512 * p, row = idx >> 7, c8 = idx & 127;
            f32x4 a = ld[2 * p], b2 = ld[2 * p + 1]; const u32x4 mm = lm[p];
            a[0] += __builtin_bit_cast(float, mm.x << 16); a[1] += __builtin_bit_cast(float, mm.x & 0xffff0000u); a[2] += __builtin_bit_cast(float, mm.y << 16); a[3] += __builtin_bit_cast(float, mm.y & 0xffff0000u);
            b2[0] += __builtin_bit_cast(float, mm.z << 16); b2[1] += __builtin_bit_cast(float, mm.z & 0xffff0000u); b2[2] += __builtin_bit_cast(float, mm.w << 16); b2[3] += __builtin_bit_cast(float, mm.w & 0xffff0000u);
            *(LAS f32x4*)(XT + row * 1028 + 8 * c8) = a; *(LAS f32x4*)(XT + row * 1028 + 8 * c8 + 4) = b2; }
        __syncthreads();
        if (it + 1 < 8) P6_FETCH(tok + 16);
        f32x4 acc[3];
#pragma unroll
        for (int nt = 0; nt < 3; ++nt) acc[nt] = (f32x4){0.f, 0.f, 0.f, 0.f};
        float ssp = 0.f;
#pragma unroll
        for (int s = 0; s < 4; ++s) {
            const f32x4 a0 = *(const LAS f32x4*)(XT + tl * 1028 + 128 * w + 32 * s + 8 * g), a1 = *(const LAS f32x4*)(XT + tl * 1028 + 128 * w + 32 * s + 8 * g + 4);
            const float a[8] = {a0[0], a0[1], a0[2], a0[3], a1[0], a1[1], a1[2], a1[3]};
#pragma unroll
            for (int j = 0; j < 8; ++j) ssp += a[j] * a[j];
            u32x4 ahi_, alo_; split_hi_lo(a, ahi_, alo_); const bf16x8 Ahi = __builtin_bit_cast(bf16x8, ahi_), Alo = __builtin_bit_cast(bf16x8, alo_);
#pragma unroll
            for (int nt = 0; nt < 3; ++nt) {
                acc[nt] = __builtin_amdgcn_mfma_f32_16x16x32_bf16(Ahi, Bhi[nt][s], acc[nt], 0, 0, 0);
                acc[nt] = __builtin_amdgcn_mfma_f32_16x16x32_bf16(Ahi, Blo[nt][s], acc[nt], 0, 0, 0);
                acc[nt] = __builtin_amdgcn_mfma_f32_16x16x32_bf16(Alo, Bhi[nt][s], acc[nt], 0, 0, 0);
            }
        }
        ssp += __shfl_xor(ssp, 16); ssp += __shfl_xor(ssp, 32);
        if (g == 0) SSP[w * 16 + tl] = ssp;
#pragma unroll
        for (int nt = 0; nt < 3; ++nt)
#pragma unroll
            for (int r = 0; r < 4; ++r) PART[(w * 16 + 4 * g + r) * 48 + 16 * nt + tl] = acc[nt][r];
        __syncthreads();
        for (int idx = tid; idx < 768; idx += 512) { const int t = idx / 48, c = idx - t * 48;
            float s = 0.f, ss = 0.f;
#pragma unroll
            for (int ww = 0; ww < 8; ++ww) { s += PART[(ww * 16 + t) * 48 + c]; ss += SSP[ww * 16 + t]; }
            const float r = rsqrtf(ss * (1.f / 1024.f) + 1e-6f);
            LOG[t * 48 + c] = r * s + CONST[c];
            if (c == 0) RINV[t] = r; }
        __syncthreads();
        if (tid < 16) {
            const LAS float* lg = LOG + tid * 48;
            int gi = 0; float gmax = lg[0];
#pragma unroll
            for (int i = 1; i < 4; ++i) { const float v = lg[i]; if (v > gmax) { gmax = v; gi = i; } }
            float den = 0.f;
#pragma unroll
            for (int i = 0; i < 4; ++i) den += __expf(lg[i] - gmax);
            const float ggate = 1.f / den;
            int i0 = 0; float v0 = lg[4 + gi * 8];
#pragma unroll
            for (int i = 1; i < 8; ++i) { const float v = lg[4 + gi * 8 + i]; if (v > v0) { v0 = v; i0 = i; } }
            int i1 = -1; float v1 = 0.f;
#pragma unroll
            for (int i = 0; i < 8; ++i) { const float v = lg[4 + gi * 8 + i]; if (i != i0 && (i1 < 0 || v > v1)) { v1 = v; i1 = i; } }
            const float ex = __expf(v1 - v0);
            const float p0 = 1.f / (1.f + ex), p1 = ex / (1.f + ex);
            const int e0 = gi * 8 + i0, e1 = gi * 8 + i1, aid = 2 * (tok + tid);
            *(float2*)(asg_gate + aid) = make_float2(p0 * ggate, p1 * ggate);
            const int j = it * 32 + 2 * tid;
            AEXP[j] = e0; AEXP[j + 1] = e1;
            APOS[j] = __hip_atomic_fetch_add(&LCNT[e0], 1, __ATOMIC_RELAXED, __HIP_MEMORY_SCOPE_WORKGROUP); APOS[j + 1] = __hip_atomic_fetch_add(&LCNT[e1], 1, __ATOMIC_RELAXED, __HIP_MEMORY_SCOPE_WORKGROUP);
        }
        {
            const int row = tid >> 5; const float r = RINV[row];
#pragma unroll
            for (int q = 0; q < 4; ++q) { const int col = 8 * (tid & 31) + 256 * q;
                const f32x4 x0 = *(const LAS f32x4*)(XT + row * 1028 + col), x1v = *(const LAS f32x4*)(XT + row * 1028 + col + 4);
                const f32x4 p0 = *(const LAS f32x4*)(GP + col), p1 = *(const LAS f32x4*)(GP + col + 4), s0 = *(const LAS f32x4*)(SH + col), s1 = *(const LAS f32x4*)(SH + col + 4);
                const f32x4 y0 = x0 * r * p0 + s0, y1 = x1v * r * p1 + s1;
                u32x4 o; o.x = pk2(y0[0], y0[1]); o.y = pk2(y0[2], y0[3]); o.z = pk2(y1[0], y1[1]); o.w = pk2(y1[2], y1[3]);
                *(u32x4*)(h2 + (size_t)(tok + row) * 1024 + col) = o;
                u32x4 xb; xb.x = pk2(x0[0], x0[1]); xb.y = pk2(x0[2], x0[3]); xb.z = pk2(x1v[0], x1v[1]); xb.w = pk2(x1v[2], x1v[3]);
                *(u32x4*)(x1b + (size_t)(tok + row) * 1024 + col) = xb; }
        }
        __syncthreads();
    }
    if (tid < 32) LBASE[tid] = (int)atomicAdd(cnt + tid, (unsigned)LCNT[tid]);
    __syncthreads();
    if (tid < 256) { const int e = AEXP[tid], pos = LBASE[e] + APOS[tid];
        const int aid = 2 * (tok0 + (tid >> 5) * 16 + ((tid & 31) >> 1)) + (tid & 1);
        list[e * CAPX + pos] = aid; }
    __syncthreads();
#undef P6_FETCH
}

__device__ __forceinline__ void moe_table(const Frame& F) {
    LAS int* ts = (LAS int*)(F.lds + MOE_OFF); LAS int* cn = ts + 33;
    if (F.tid == 0) { int acc = 0; for (int e = 0; e < 32; ++e) { const int c = (int)__hip_atomic_load(F.ctl + CW_CNT + e, RLX_AGENT); cn[e] = c; ts[e] = acc; acc += (c + 255) >> 8; } ts[32] = acc; }
    __syncthreads();
}
struct MoeOrder {
    const char* Abase; const char* Bbase; const int* list; LAS int* ts; LAS int* cn; int K; size_t strideB_e; int G, c; bool gather;
    __device__ __forceinline__ bool next(int i, pg8::Unit& u) const {
        const int total = __builtin_amdgcn_readfirstlane(ts[32]) * 4;
        const int L = i * G + c; if (L >= total) return false;
        const int mg = L >> 2, pn = L & 3;
        int e = 0;
        for (int j = 1; j < 32; ++j) e += (ts[j] <= mg) ? 1 : 0;
        e = __builtin_amdgcn_readfirstlane(e);
        const int mt = mg - __builtin_amdgcn_readfirstlane(ts[e]); const int ce = __builtin_amdgcn_readfirstlane(cn[e]);
        u.pm = mg; u.pn = pn; u.e = e * CAPX + mt * 256; u.nvalid = (ce - mt * 256 < 256) ? (ce - mt * 256) : 256;
        u.A = gather ? Abase : Abase + (size_t)mg * 256 * K * 2;
        u.B = Bbase + (size_t)e * strideB_e + (size_t)pn * 256 * K * 2;
        return true;
    }
    __device__ __forceinline__ unsigned a_row_off(const pg8::Unit& u, int r) const {
        if (!gather) return (unsigned)(r * K * 2);
        const int a = (r < u.nvalid) ? list[u.e + r] : 0;
        return (unsigned)(a >> 1) * (unsigned)(K * 2);
    }
    __device__ __forceinline__ void a_ready(const pg8::Unit&) const {}
    __device__ __forceinline__ void done(const pg8::Unit&) const {}
};
struct MkEpiSwiglu {
    static constexpr bool PERM = true;
    bf16* H;
    __device__ __forceinline__ void operator()(const f32x4 (&acc)[2][2][4][2], const pg8::Unit& u, int wr, int wc, int fr, int fq) const {
        const int row0 = u.pm * 256 + wr * 64 + fr, col0 = u.pn * 128 + wc * 32 + 8 * fq;
#pragma unroll
        for (int ai = 0; ai < 2; ++ai)
#pragma unroll
            for (int m = 0; m < 4; ++m) {
                float hv[8];
#pragma unroll
                for (int n = 0; n < 2; ++n)
#pragma unroll
                    for (int j = 0; j < 4; ++j) { const float gt = acc[ai][0][m][n][j], up = acc[ai][1][m][n][j]; hv[4 * n + j] = gt / (1.f + __expf(-gt)) * up; }
                u32x4 o; o.x = pk2(hv[0], hv[1]); o.y = pk2(hv[2], hv[3]); o.z = pk2(hv[4], hv[5]); o.w = pk2(hv[6], hv[7]);
                *(u32x4*)(H + (size_t)(row0 + ai * 128 + m * 16) * 512 + col0) = o; }
    }
};
struct MkEpiSlot {
    static constexpr bool PERM = true;
    bf16* slot; const int* list; const float* gate;
    __device__ __forceinline__ void operator()(const f32x4 (&acc)[2][2][4][2], const pg8::Unit& u, int wr, int wc, int fr, int fq) const {
        const int col0 = u.pn * 256 + wc * 32 + 8 * fq;
#pragma unroll
        for (int ai = 0; ai < 2; ++ai)
#pragma unroll
            for (int m = 0; m < 4; ++m) { const int r = ai * 128 + wr * 64 + m * 16 + fr;
                if (r < u.nvalid) { const int aid = list[u.e + r]; const float gt = gate[aid]; bf16* rowp = slot + (size_t)aid * 1024 + col0;
#pragma unroll
                    for (int bj = 0; bj < 2; ++bj) { const f32x4 v0 = acc[ai][bj][m][0] * gt, v1 = acc[ai][bj][m][1] * gt;
                        u32x4 o; o.x = pk2(v0[0], v0[1]); o.y = pk2(v0[2], v0[3]); o.z = pk2(v1[0], v1[1]); o.w = pk2(v1[2], v1[3]);
                        *(u32x4*)(rowp + bj * 128) = o; } } }
    }
};

__device__ __forceinline__ void p9_final(const Frame& F) {
    float* xo = F.out; const bf16* slot = (const bf16*)(F.ws + WS_SLOT); const bf16* x1b = (const bf16*)(F.ws + WS_X1B); const float* mod = (const float*)(F.ws + WS_MOD); const float* fg = F.in[26];
    const int lane = F.lane;
    for (int row = blockIdx.x * 8 + F.wave; row < T_TOK; row += F.G * 8) {
        const int b = row >> 12;
        float v[16];
#pragma unroll
        for (int q = 0; q < 2; ++q) { const int off = q * 512 + 8 * lane;
            const u32x4 xb = *(const u32x4*)(x1b + (size_t)row * 1024 + off);
            const f32x4 g0 = *(const f32x4*)(mod + b * 6144 + 5 * 1024 + off), g1 = *(const f32x4*)(mod + b * 6144 + 5 * 1024 + off + 4);
            const u32x4 sa = *(const u32x4*)(slot + (size_t)(2 * row) * 1024 + off), sb = *(const u32x4*)(slot + (size_t)(2 * row + 1) * 1024 + off);
            float m[8], t[8];
#pragma unroll
            for (int j = 0; j < 4; ++j) { m[2 * j] = __builtin_bit_cast(float, sa[j] << 16) + __builtin_bit_cast(float, sb[j] << 16);
                m[2 * j + 1] = __builtin_bit_cast(float, sa[j] & 0xffff0000u) + __builtin_bit_cast(float, sb[j] & 0xffff0000u);
                t[2 * j] = __builtin_bit_cast(float, xb[j] << 16); t[2 * j + 1] = __builtin_bit_cast(float, xb[j] & 0xffff0000u); }
#pragma unroll
            for (int j = 0; j < 4; ++j) { v[8 * q + j] = t[j] + g0[j] * m[j]; v[8 * q + 4 + j] = t[4 + j] + g1[j] * m[4 + j]; } }
        float ss = 0.f;
#pragma unroll
        for (int i = 0; i < 16; ++i) ss += v[i] * v[i];
        ss = wave_sum(ss);
        const float r = rsqrtf(ss * (1.f / 1024.f) + 1e-6f);
#pragma unroll
        for (int q = 0; q < 2; ++q) { const int off = q * 512 + 8 * lane;
            const f32x4 f0 = *(const f32x4*)(fg + off), f1 = *(const f32x4*)(fg + off + 4);
            f32x4 o0, o1;
#pragma unroll
            for (int j = 0; j < 4; ++j) { o0[j] = v[8 * q + j] * r * f0[j]; o1[j] = v[8 * q + 4 + j] * r * f1[j]; }
            *(f32x4*)(xo + (size_t)row * 1024 + off) = o0; *(f32x4*)(xo + (size_t)row * 1024 + off + 4) = o1; }
    }
}

typedef short s16x4 __attribute__((ext_vector_type(4)));
typedef unsigned u32x2 __attribute__((ext_vector_type(2)));
constexpr int TP = 272;
constexpr int TILE_B = 64 * TP;
constexpr int SP_ = 144;
constexpr size_t WS_UC = 304 * MiB, WS_Q = 336 * MiB, WS_K = 368 * MiB;
constexpr size_t WS_STATE = 400 * MiB; constexpr int STATE_STRIDE = 66560;
constexpr float NEG_BIG = -1e30f;

__device__ __forceinline__ bf16x8 frag_row(const LAS unsigned char* tile, int pitch, int row, int col) { return *(const LAS bf16x8*)(tile + row * pitch + col * 2); }
__device__ __forceinline__ bf16x8 frag_tr(const LAS unsigned char* tile, int ks, int c, int lane) {
    const int g = lane >> 4, q = (lane & 15) >> 2, p = lane & 3;
    const LAS unsigned char* a0 = tile + (32 * ks + 8 * g + q) * TP + (16 * c + 4 * p) * 2;
    const s16x4 lo = __builtin_amdgcn_ds_read_tr16_b64_v4i16((LAS s16x4*)a0);
    const s16x4 hi = __builtin_amdgcn_ds_read_tr16_b64_v4i16((LAS s16x4*)(a0 + 4 * TP));
    bf16x8 r; r[0] = lo[0]; r[1] = lo[1]; r[2] = lo[2]; r[3] = lo[3]; r[4] = hi[0]; r[5] = hi[1]; r[6] = hi[2]; r[7] = hi[3]; return r;
}
__device__ __forceinline__ void tile_load(const Frame& F, LAS unsigned char* tile, const bf16* src, int ld) {
    const int row = F.tid >> 3, seg = F.tid & 7;
    const u32x4 a = *(const u32x4*)(src + (size_t)row * ld + seg * 16), b = *(const u32x4*)(src + (size_t)row * ld + seg * 16 + 8);
    *(LAS u32x4*)(tile + row * TP + seg * 32) = a; *(LAS u32x4*)(tile + row * TP + seg * 32 + 16) = b;
}
struct TilePf { u32x4 a, b; };
__device__ __forceinline__ TilePf tile_fetch(const Frame& F, const bf16* src, int ld) { const int row = F.tid >> 3, seg = F.tid & 7; TilePf p;
    p.a = *(const u32x4*)(src + (size_t)row * ld + seg * 16); p.b = *(const u32x4*)(src + (size_t)row * ld + seg * 16 + 8); return p; }
__device__ __forceinline__ void tile_put(const Frame& F, LAS unsigned char* tile, const TilePf& p) { const int row = F.tid >> 3, seg = F.tid & 7;
    *(LAS u32x4*)(tile + row * TP + seg * 32) = p.a; *(LAS u32x4*)(tile + row * TP + seg * 32 + 16) = p.b; }
__device__ __forceinline__ void tile_store(const Frame& F, const LAS unsigned char* tile, bf16* dst, int ld) {
    const int row = F.tid >> 3, seg = F.tid & 7;
    const u32x4 a = *(const LAS u32x4*)(tile + row * TP + seg * 32), b = *(const LAS u32x4*)(tile + row * TP + seg * 32 + 16);
    *(u32x4*)(dst + (size_t)row * ld + seg * 16) = a; *(u32x4*)(dst + (size_t)row * ld + seg * 16 + 8) = b;
}
__device__ __forceinline__ void unpack8(const u32x4 v, float (&f)[8]) {
#pragma unroll
    for (int j = 0; j < 4; ++j) { f[2 * j] = __builtin_bit_cast(float, v[j] << 16); f[2 * j + 1] = __builtin_bit_cast(float, v[j] & 0xffff0000u); }
}
__device__ __forceinline__ u32x4 pack8(const float (&f)[8]) { u32x4 o; o.x = pk2(f[0], f[1]); o.y = pk2(f[2], f[3]); o.z = pk2(f[4], f[5]); o.w = pk2(f[6], f[7]); return o; }
__device__ __forceinline__ float log_sigmoid_f(float f) { return fminf(f, 0.f) - log1pf(__expf(-fabsf(f))); }

struct ChunkGates { float c, b, pm, b_last, pm_last; };
__device__ __forceinline__ ChunkGates chunk_gates(float xi, float xf, float bi, float bfg, float m_prev, int lane) {
    ChunkGates G;
    const float ig = xi + bi;
    float b = log_sigmoid_f(xf + bfg);
#pragma unroll
    for (int o = 1; o < 64; o <<= 1) { const float v = __shfl_up(b, o); if (lane >= o) b += v; }
    const float c = ig - b;
    float pm = c;
#pragma unroll
    for (int o = 1; o < 64; o <<= 1) { const float v = __shfl_up(pm, o); if (lane >= o) pm = fmaxf(pm, v); }
    pm = fmaxf(pm, m_prev);
    G.c = c; G.b = b; G.pm = pm; G.b_last = __shfl(b, 63); G.pm_last = __shfl(pm, 63);
    return G;
}
__device__ __forceinline__ void state_update(const LAS unsigned char* Kt, const LAS unsigned char* Vt, f32x4 (&Ct)[8], f32x4& nacc, const ChunkGates& G, float m_prev, int w, int lane) {
    const int tl = lane & 15, gq = lane >> 4;
    const float a_prev = __expf(m_prev - G.pm_last);
    const float ws = __expf(G.c - G.pm_last);
#pragma unroll
    for (int dt = 0; dt < 8; ++dt) Ct[dt] = Ct[dt] * a_prev;
    nacc = nacc * a_prev;
#pragma unroll
    for (int ss = 0; ss < 2; ++ss) {
        float wj[8];
#pragma unroll
        for (int j = 0; j < 8; ++j) wj[j] = __shfl(ws, 32 * ss + 8 * gq + j);
        const bf16x8 vraw = frag_tr(Vt, ss, w, lane);
        float vf[8]; unpack8(__builtin_bit_cast(u32x4, vraw), vf);
        float wcol[8];
#pragma unroll
        for (int j = 0; j < 8; ++j) { vf[j] *= wj[j]; wcol[j] = (tl == 0) ? wj[j] : 0.f; }
        const bf16x8 vw = __builtin_bit_cast(bf16x8, pack8(vf)), wc = __builtin_bit_cast(bf16x8, pack8(wcol));
#pragma unroll
        for (int dt = 0; dt < 8; ++dt) { const bf16x8 kf = frag_tr(Kt, ss, dt, lane);
            Ct[dt] = __builtin_amdgcn_mfma_f32_16x16x32_bf16(kf, vw, Ct[dt], 0, 0, 0);
            if (dt == w) nacc = __builtin_amdgcn_mfma_f32_16x16x32_bf16(kf, wc, nacc, 0, 0, 0); }
    }
}

__device__ __forceinline__ void p3_fetch(const Frame& F, const bf16* proj, const float* gif, int tok, int tt0, int g, TilePf& pu, TilePf& pvv, TilePf& ph0, TilePf& phalo, float& gxi, float& gxf) {
    const int tid = F.tid;
    gxi = gif[(size_t)(tok + F.lane) * 8 + g]; gxf = gif[(size_t)(tok + F.lane) * 8 + 4 + g];
    pu = tile_fetch(F, proj + (size_t)tok * 2048 + g * 128, 2048);
    pvv = tile_fetch(F, proj + (size_t)tok * 2048 + 512 + g * 128, 2048);
    ph0 = tile_fetch(F, proj + (size_t)tok * 2048 + 1536 + g * 128, 2048);
    phalo.a = (u32x4){0u, 0u, 0u, 0u}; phalo.b = phalo.a;
    if (tid < 120) { const int r = tid >> 3, seg = tid & 7;
        if (tt0 - 15 + r >= 0) { const bf16* src = proj + (size_t)(tok - 15 + r) * 2048 + 1536 + g * 128 + seg * 16; phalo.a = *(const u32x4*)src; phalo.b = *(const u32x4*)(src + 8); } }
    else if (tid >= 128 && tid < 152) { const int r = (tid - 128) >> 3, seg = tid & 7;
        if (tt0 - 3 + r >= 0) { const bf16* src = proj + (size_t)(tok - 3 + r) * 2048 + g * 128 + seg * 16; phalo.a = *(const u32x4*)src; phalo.b = *(const u32x4*)(src + 8); } }
}
constexpr int P3_UC = 0, P3_V = TILE_B, P3_PH = 2 * TILE_B, P3_Q = 2 * TILE_B + 80 * TP, P3_K = P3_Q + TILE_B, P3_PO = P3_K + TILE_B, P3_Y = P3_PO + TILE_B, P3_CW = P3_Y + TILE_B, P3_U = RING_BYTES + 1024;
static_assert(P3_CW + 5 * 128 * 4 <= RING_BYTES, "P3 LDS map");
template <int TV> __device__ __forceinline__ void p3_unit(const Frame& F_, int unit) {
    const Frame& F = F_;
    const int b = unit >> 5, sp = (unit >> 2) & 7, g = unit & 3;
    const int tid = F.tid, lane = F.lane, w = F.wave, tl = lane & 15, gq = lane >> 4;
    const bf16* proj = F.proj; const float* gif = (const float*)(F.ws + WS_GIF);
    bf16* ucg = (bf16*)(F.ws + WS_UC); bf16* qg = (bf16*)(F.ws + WS_Q); bf16* kg = (bf16*)(F.ws + WS_K); bf16* yg = (bf16*)(F.ws + WS_ACT1);
    LAS unsigned char* L = F.lds;
    LAS float* CW = (LAS float*)(L + P3_CW);
    if (tid < 128) { CW[4 * 128 + tid] = F.in[7][g * 128 + tid]; }
    { const int j = tid >> 7, c = tid & 127; CW[j * 128 + c] = F.in[6][j * 512 + g * 128 + c]; }
    const float bi = F.in[10][g], bfg = F.in[11][g];
    f32x4 Ct[8]; f32x4 nacc = (f32x4){0.f, 0.f, 0.f, 0.f};
#pragma unroll
    for (int dt = 0; dt < 8; ++dt) Ct[dt] = (f32x4){0.f, 0.f, 0.f, 0.f};
    float m = NEG_BIG, btot = 0.f;
    const int win = 2 << g;
    __syncthreads();
    TilePf pu, pvv, ph0, phalo; float gxi, gxf;
    p3_fetch(F, proj, gif, b * 4096 + sp * 512, sp * 512, g, pu, pvv, ph0, phalo, gxi, gxf);
    const Frame& F0 = F;
    for (int ch = 0; ch < 8; ++ch) {
        int tid_o = F0.tid; asm volatile("" : "+v"(tid_o));
        Frame F = F0; F.tid = tid_o; F.lane = tid_o & 63;
        const int tid = F.tid, lane = F.lane, tl = lane & 15, gq = lane >> 4;
        const int tt0 = sp * 512 + ch * 64, tok = b * 4096 + tt0;
        {
            const int row = tid >> 3, seg = tid & 7;
            *(LAS u32x4*)(L + P3_U + (3 + row) * TP + seg * 32) = pu.a; *(LAS u32x4*)(L + P3_U + (3 + row) * TP + seg * 32 + 16) = pu.b;
            tile_put(F, L + P3_V, pvv);
            *(LAS u32x4*)(L + P3_PH + (15 + row) * TP + seg * 32) = ph0.a; *(LAS u32x4*)(L + P3_PH + (15 + row) * TP + seg * 32 + 16) = ph0.b;
            if (tid < 120) { *(LAS u32x4*)(L + P3_PH + row * TP + seg * 32) = phalo.a; *(LAS u32x4*)(L + P3_PH + row * TP + seg * 32 + 16) = phalo.b; }
            else if (tid >= 128 && tid < 152) { const int r = (tid - 128) >> 3; *(LAS u32x4*)(L + P3_U + r * TP + seg * 32) = phalo.a; *(LAS u32x4*)(L + P3_U + r * TP + seg * 32 + 16) = phalo.b; }
        }
        __syncthreads();
        {
            const int row = tid >> 3, cg = tid & 7;
            float a[16];
#pragma unroll
            for (int i = 0; i < 16; ++i) a[i] = CW[4 * 128 + 16 * cg + i];
#pragma unroll
            for (int j = 0; j < 4; ++j) { float x0[8], x1[8]; unpack8(*(const LAS u32x4*)(L + P3_U + (row + j) * TP + cg * 32), x0); unpack8(*(const LAS u32x4*)(L + P3_U + (row + j) * TP + cg * 32 + 16), x1);
#pragma unroll
                for (int i = 0; i < 8; ++i) { a[i] += CW[j * 128 + 16 * cg + i] * x0[i]; a[8 + i] += CW[j * 128 + 16 * cg + 8 + i] * x1[i]; } }
            float o0[8], o1[8];
#pragma unroll
            for (int i = 0; i < 8; ++i) { o0[i] = silu_f(a[i]); o1[i] = silu_f(a[8 + i]); }
            const u32x4 u0 = pack8(o0), u1 = pack8(o1);
            *(LAS u32x4*)(L + P3_UC + row * TP + cg * 32) = u0; *(LAS u32x4*)(L + P3_UC + row * TP + cg * 32 + 16) = u1;
            if (!(TV & 1)) { *(u32x4*)(ucg + (size_t)(tok + row) * 512 + g * 128 + 16 * cg) = u0; *(u32x4*)(ucg + (size_t)(tok + row) * 512 + g * 128 + 16 * cg + 8) = u1; }
        }
        const ChunkGates G = chunk_gates(gxi, gxf, bi, bfg, m, lane);
        __syncthreads();
        bf16x8 Wq[4], Wk[4];
#pragma unroll
        for (int s = 0; s < 4; ++s) { const size_t o = (size_t)g * 16384 + (size_t)(16 * w + tl) * 128 + 32 * s + 8 * gq;
            Wq[s] = *(const bf16x8*)((const bf16*)(F.ws + WS_WQ) + o); Wk[s] = *(const bf16x8*)((const bf16*)(F.ws + WS_WK) + o); }
        if (ch + 1 < 8) p3_fetch(F, proj, gif, tok + 64, tt0 + 64, g, pu, pvv, ph0, phalo, gxi, gxf);
        {
            f32x4 aq[4], ak[4];
#pragma unroll
            for (int mt = 0; mt < 4; ++mt) { aq[mt] = (f32x4){0.f, 0.f, 0.f, 0.f}; ak[mt] = (f32x4){0.f, 0.f, 0.f, 0.f}; }
            __builtin_amdgcn_sched_barrier(0);
#pragma unroll
            for (int mt = 0; mt < 4; ++mt) {
                if (!(TV & 4))
#pragma unroll
                for (int s = 0; s < 4; ++s) { const bf16x8 uf = frag_row(L + P3_UC, TP, 16 * mt + tl, 32 * s + 8 * gq);
                    aq[mt] = __builtin_amdgcn_mfma_f32_16x16x32_bf16(Wq[s], uf, aq[mt], 0, 0, 0);
                    ak[mt] = __builtin_amdgcn_mfma_f32_16x16x32_bf16(Wk[s], uf, ak[mt], 0, 0, 0); }
                const float qs = 0.08838834764831845f;
                u32x2 qv, kv; qv.x = pk2(aq[mt][0] * qs, aq[mt][1] * qs); qv.y = pk2(aq[mt][2] * qs, aq[mt][3] * qs); kv.x = pk2(ak[mt][0], ak[mt][1]); kv.y = pk2(ak[mt][2], ak[mt][3]);
                *(LAS u32x2*)(L + P3_Q + (16 * mt + tl) * TP + (16 * w + 4 * gq) * 2) = qv; *(LAS u32x2*)(L + P3_K + (16 * mt + tl) * TP + (16 * w + 4 * gq) * 2) = kv;
                __builtin_amdgcn_sched_barrier(0); }
            const int row = tid >> 3, cg = tid & 7, tt = tt0 + row;
            const int cntw = (tt + 1 < win) ? (tt + 1) : win;
            float s0[8], s1[8];
#pragma unroll
            for (int i = 0; i < 8; ++i) { s0[i] = 0.f; s1[i] = 0.f; }
            for (int j = 0; j < cntw; ++j) { float x0[8], x1[8];
                unpack8(*(const LAS u32x4*)(L + P3_PH + (row + 15 - j) * TP + cg * 32), x0); unpack8(*(const LAS u32x4*)(L + P3_PH + (row + 15 - j) * TP + cg * 32 + 16), x1);
#pragma unroll
                for (int i = 0; i < 8; ++i) { s0[i] += x0[i]; s1[i] += x1[i]; } }
            float c0[8], c1[8]; unpack8(*(const LAS u32x4*)(L + P3_PH + (row + 15) * TP + cg * 32), c0); unpack8(*(const LAS u32x4*)(L + P3_PH + (row + 15) * TP + cg * 32 + 16), c1);
            const float inv = 1.f / (float)cntw;
#pragma unroll
            for (int i = 0; i < 8; ++i) { s0[i] = s0[i] * inv - c0[i]; s1[i] = s1[i] * inv - c1[i]; }
            *(LAS u32x4*)(L + P3_PO + row * TP + cg * 32) = pack8(s0); *(LAS u32x4*)(L + P3_PO + row * TP + cg * 32 + 16) = pack8(s1);
        }
        __syncthreads();
        {
            if (!(TV & 1)) { tile_store(F, L + P3_Q, qg + (size_t)tok * 512 + g * 128, 512);
            tile_store(F, L + P3_K, kg + (size_t)tok * 512 + g * 128, 512); }
            bf16x8 Wp[4];
#pragma unroll
            for (int s = 0; s < 4; ++s) Wp[s] = *(const bf16x8*)((const bf16*)(F.ws + WS_WPOOL) + (size_t)g * 16384 + (size_t)(16 * w + tl) * 128 + 32 * s + 8 * gq);
            const f32x4 bp = *(const f32x4*)(F.in[15] + g * 128 + 16 * w + 4 * gq), ps = *(const f32x4*)(F.in[16] + g * 128 + 16 * w + 4 * gq);
            f32x4 ap[4];
#pragma unroll
            for (int mt = 0; mt < 4; ++mt) ap[mt] = (f32x4){0.f, 0.f, 0.f, 0.f};
            __builtin_amdgcn_sched_barrier(0);
#pragma unroll
            for (int mt = 0; mt < 4; ++mt) {
                if (!(TV & 4))
#pragma unroll
                for (int s = 0; s < 4; ++s) ap[mt] = __builtin_amdgcn_mfma_f32_16x16x32_bf16(Wp[s], frag_row(L + P3_PO, TP, 16 * mt + tl, 32 * s + 8 * gq), ap[mt], 0, 0, 0);
                const f32x4 y = (ap[mt] + bp) * ps; u32x2 yv; yv.x = pk2(y[0], y[1]); yv.y = pk2(y[2], y[3]);
                *(LAS u32x2*)(L + P3_Y + (16 * mt + tl) * TP + (16 * w + 4 * gq) * 2) = yv;
                __builtin_amdgcn_sched_barrier(0); }
            if (!(TV & 2)) state_update(L + P3_K, L + P3_V, Ct, nacc, G, m, w, lane);
            m = G.b_last + G.pm_last; btot += G.b_last;
        }
        __syncthreads();
        if (!(TV & 1)) tile_store(F, L + P3_Y, yg + (size_t)tok * 1024 + 512 + g * 128, 1024);
    }
    unsigned char* st = F.ws + WS_STATE + (size_t)unit * STATE_STRIDE;
    if (!(TV & 1)) {
#pragma unroll
    for (int dt = 0; dt < 8; ++dt) *(f32x4*)(st + ((size_t)(w * 8 + dt) * 64 + lane) * 16) = Ct[dt];
    if (tl == 0) *(f32x4*)(st + 65536 + (16 * w + 4 * gq) * 4) = nacc;
    if (tid == 0) { *(float*)(st + 66048) = m; *(float*)(st + 66052) = btot; }
    } else { asm volatile("" :: "v"(Ct[0][0] + Ct[7][3] + nacc[0] + m + btot)); }
    __syncthreads();
}

constexpr int P4_Q = 0, P4_K = TILE_B, P4_V = 2 * TILE_B, P4_UC = 3 * TILE_B, P4_O = 4 * TILE_B, P4_Y = 5 * TILE_B, P4_S = 6 * TILE_B, P4_RS = P4_S + 64 * SP_, P4_QN = P4_RS + 512, P4_SSQ = P4_QN + 256, P4_NV = P4_SSQ + 2048;
static_assert(P4_NV + 256 <= RING_BYTES, "P4 LDS map");
template <int TV> __device__ __forceinline__ void p4_unit(const Frame& F, int unit, bf16* yg) {
    const int b = unit >> 5, sp = (unit >> 2) & 7, h = unit & 3;
    const int tid = F.tid, lane = F.lane, w = F.wave, tl = lane & 15, gq = lane >> 4;
    const bf16* proj = F.proj; const float* gif = (const float*)(F.ws + WS_GIF);
    const bf16* ucg = (const bf16*)(F.ws + WS_UC); const bf16* qg = (const bf16*)(F.ws + WS_Q); const bf16* kg = (const bf16*)(F.ws + WS_K);
    LAS unsigned char* L = F.lds;
    LAS float* RS = (LAS float*)(L + P4_RS); LAS float* QN = (LAS float*)(L + P4_QN); LAS float* SSQ = (LAS float*)(L + P4_SSQ); LAS bf16* NV = (LAS bf16*)(L + P4_NV);
    const float bi = F.in[10][h], bfg = F.in[11][h];
    const f32x4 ng = *(const f32x4*)(F.in[12] + h * 128 + 16 * w + 4 * gq), sk = *(const f32x4*)(F.in[13] + h * 128 + 16 * w + 4 * gq);
    f32x4 Ct[8]; f32x4 nacc = (f32x4){0.f, 0.f, 0.f, 0.f};
#pragma unroll
    for (int dt = 0; dt < 8; ++dt) Ct[dt] = (f32x4){0.f, 0.f, 0.f, 0.f};
    float m = 0.f;
    for (int i = 0; i < sp; ++i) {
        const unsigned char* st = F.ws + WS_STATE + (size_t)((b * 8 + i) * 4 + h) * STATE_STRIDE;
        const float mloc = *(const float*)(st + 66048), bt = *(const float*)(st + 66052);
        const float mn = fmaxf(bt + m, mloc), fa = __expf(bt + m - mn), fb = __expf(mloc - mn);
#pragma unroll
        for (int dt = 0; dt < 8; ++dt) Ct[dt] = Ct[dt] * fa + *(const f32x4*)(st + ((size_t)(w * 8 + dt) * 64 + lane) * 16) * fb;
        nacc = nacc * fa + *(const f32x4*)(st + 65536 + (16 * w + 4 * gq) * 4) * fb;
        m = mn;
    }
    if (tl == 0) { *(LAS u32x2*)(NV + 16 * w + 4 * gq) = (u32x2){pk2(nacc[0], nacc[1]), pk2(nacc[2], nacc[3])}; }
    __syncthreads();
    TilePf pq, pk, pu, pv, po; float gxi, gxf;
    { const int t0 = b * 4096 + sp * 512;
      gxi = gif[(size_t)(t0 + lane) * 8 + h]; gxf = gif[(size_t)(t0 + lane) * 8 + 4 + h];
      pq = tile_fetch(F, qg + (size_t)t0 * 512 + h * 128, 512); pk = tile_fetch(F, kg + (size_t)t0 * 512 + h * 128, 512); pu = tile_fetch(F, ucg + (size_t)t0 * 512 + h * 128, 512);
      pv = tile_fetch(F, proj + (size_t)t0 * 2048 + 512 + h * 128, 2048); po = tile_fetch(F, proj + (size_t)t0 * 2048 + 1024 + h * 128, 2048); }
    const Frame& F0 = F;
    for (int ch = 0; ch < 8; ++ch) {
        int tid_o = F0.tid; asm volatile("" : "+v"(tid_o));
        Frame F = F0; F.tid = tid_o; F.lane = tid_o & 63;
        const int tid = F.tid, lane = F.lane, tl = lane & 15, gq = lane >> 4;
        const int tok = b * 4096 + sp * 512 + ch * 64;
        tile_put(F, L + P4_Q, pq); tile_put(F, L + P4_K, pk); tile_put(F, L + P4_UC, pu); tile_put(F, L + P4_V, pv); tile_put(F, L + P4_O, po);
        const ChunkGates G = chunk_gates(gxi, gxf, bi, bfg, m, lane);
        __syncthreads();
        if (ch + 1 < 8) {
            const int tn = tok + 64;
            gxi = gif[(size_t)(tn + lane) * 8 + h]; gxf = gif[(size_t)(tn + lane) * 8 + 4 + h];
            pq = tile_fetch(F, qg + (size_t)tn * 512 + h * 128, 512); pk = tile_fetch(F, kg + (size_t)tn * 512 + h * 128, 512); pu = tile_fetch(F, ucg + (size_t)tn * 512 + h * 128, 512);
            pv = tile_fetch(F, proj + (size_t)tn * 2048 + 512 + h * 128, 2048); po = tile_fetch(F, proj + (size_t)tn * 2048 + 1024 + h * 128, 2048);
        }
        {
            const int mt = w >> 1, st0 = 2 * (w & 1);
            const float pmt = __shfl(G.pm, 16 * mt + tl);
            float rs = 0.f;
#pragma unroll
            for (int sti = 0; sti < 2; ++sti) { const int st = st0 + sti;
                f32x4 acc = (f32x4){0.f, 0.f, 0.f, 0.f};
                if (st <= mt) {
#pragma unroll
                    for (int ds = 0; ds < 4; ++ds) acc = __builtin_amdgcn_mfma_f32_16x16x32_bf16(frag_row(L + P4_K, TP, 16 * st + tl, 32 * ds + 8 * gq), frag_row(L + P4_Q, TP, 16 * mt + tl, 32 * ds + 8 * gq), acc, 0, 0, 0);
                }
                float v[4];
#pragma unroll
                for (int r = 0; r < 4; ++r) { const int s = 16 * st + 4 * gq + r, t = 16 * mt + tl; const float cs = __shfl(G.c, s);

                    v[r] = (s <= t) ? acc[r] * __expf(cs - pmt) : 0.f; rs += v[r]; }
                *(LAS u32x2*)(L + P4_S + (16 * mt + tl) * SP_ + (16 * st + 4 * gq) * 2) = (u32x2){pk2(v[0], v[1]), pk2(v[2], v[3])};
            }
            rs += __shfl_xor(rs, 16); rs += __shfl_xor(rs, 32);
            if (gq == 0) RS[(w & 1) * 64 + 16 * mt + tl] = rs;
            if (w & 1) {
                f32x4 acc = (f32x4){0.f, 0.f, 0.f, 0.f};
#pragma unroll
                for (int ds = 0; ds < 4; ++ds) { bf16x8 nf = *(const LAS bf16x8*)(NV + 32 * ds + 8 * gq);
                    if (tl != 0) nf = (bf16x8){0, 0, 0, 0, 0, 0, 0, 0};
                    acc = __builtin_amdgcn_mfma_f32_16x16x32_bf16(nf, frag_row(L + P4_Q, TP, 16 * mt + tl, 32 * ds + 8 * gq), acc, 0, 0, 0); }
                if (gq == 0) QN[16 * mt + tl] = acc[0];
            }
        }
        __syncthreads();
        float hv[4][4];
        {
            bf16x8 Cf[4];
#pragma unroll
            for (int ds = 0; ds < 4; ++ds) { const f32x4 lo = Ct[2 * ds], hi = Ct[2 * ds + 1];
                u32x4 p; p.x = pk2(lo[0], lo[1]); p.y = pk2(lo[2], lo[3]); p.z = pk2(hi[0], hi[1]); p.w = pk2(hi[2], hi[3]); Cf[ds] = __builtin_bit_cast(bf16x8, p); }
            const bf16x8 V0 = frag_tr(L + P4_V, 0, w, lane), V1 = frag_tr(L + P4_V, 1, w, lane);
#pragma unroll
            for (int mt = 0; mt < 4; ++mt) { const int t = 16 * mt + tl;
                f32x4 acc = (f32x4){0.f, 0.f, 0.f, 0.f};
#pragma unroll
                for (int ds = 0; ds < 4; ++ds) {
                    const u32x2 q0 = *(const LAS u32x2*)(L + P4_Q + t * TP + (32 * ds + 4 * gq) * 2), q1 = *(const LAS u32x2*)(L + P4_Q + t * TP + (32 * ds + 16 + 4 * gq) * 2);
                    const u32x4 qq = {q0.x, q0.y, q1.x, q1.y};
                    acc = __builtin_amdgcn_mfma_f32_16x16x32_bf16(Cf[ds], __builtin_bit_cast(bf16x8, qq), acc, 0, 0, 0); }
                const float pmt = __shfl(G.pm, t), bt = __shfl(G.b, t);
                const float a_inter = __expf(m - pmt);
                acc = acc * a_inter;
                acc = __builtin_amdgcn_mfma_f32_16x16x32_bf16(V0, frag_row(L + P4_S, SP_, t, 8 * gq), acc, 0, 0, 0);
                acc = __builtin_amdgcn_mfma_f32_16x16x32_bf16(V1, frag_row(L + P4_S, SP_, t, 32 + 8 * gq), acc, 0, 0, 0);
                const float den = a_inter * QN[t] + RS[t] + RS[64 + t];
                const float dn = fmaxf(fabsf(den), __expf(-(bt + pmt)));
                const float rinv = 1.f / dn;
                float ssq = 0.f;
#pragma unroll
                for (int r = 0; r < 4; ++r) { hv[mt][r] = acc[r] * rinv; ssq += hv[mt][r] * hv[mt][r]; }
                ssq += __shfl_xor(ssq, 16); ssq += __shfl_xor(ssq, 32);
                if (gq == 0) SSQ[w * 64 + t] = ssq;
            }
        }
        __syncthreads();
        {
#pragma unroll
            for (int mt = 0; mt < 4; ++mt) { const int t = 16 * mt + tl;
                float ss = 0.f;
#pragma unroll
                for (int ww = 0; ww < 8; ++ww) ss += SSQ[ww * 64 + t];
                const float rn = rsqrtf(ss * (1.f / 128.f) + 1e-6f);
                const u32x2 ov = *(const LAS u32x2*)(L + P4_O + t * TP + (16 * w + 4 * gq) * 2), uv = *(const LAS u32x2*)(L + P4_UC + t * TP + (16 * w + 4 * gq) * 2);
                const float o4[4] = {__builtin_bit_cast(float, ov.x << 16), __builtin_bit_cast(float, ov.x & 0xffff0000u), __builtin_bit_cast(float, ov.y << 16), __builtin_bit_cast(float, ov.y & 0xffff0000u)};
                const float u4[4] = {__builtin_bit_cast(float, uv.x << 16), __builtin_bit_cast(float, uv.x & 0xffff0000u), __builtin_bit_cast(float, uv.y << 16), __builtin_bit_cast(float, uv.y & 0xffff0000u)};
                float y[4];
#pragma unroll
                for (int r = 0; r < 4; ++r) {
                    y[r] = (1.f / (1.f + __expf(-o4[r]))) * (hv[mt][r] * rn * ng[r] + sk[r] * u4[r]);
                }
                *(LAS u32x2*)(L + P4_Y + t * TP + (16 * w + 4 * gq) * 2) = (u32x2){pk2(y[0], y[1]), pk2(y[2], y[3])}; }
            if (!(TV & 2)) state_update(L + P4_K, L + P4_V, Ct, nacc, G, m, w, lane);
            m = G.b_last + G.pm_last;
            if (tl == 0) { *(LAS u32x2*)(NV + 16 * w + 4 * gq) = (u32x2){pk2(nacc[0], nacc[1]), pk2(nacc[2], nacc[3])}; }
        }
        __syncthreads();
        if (!(TV & 1)) tile_store(F, L + P4_Y, yg + (size_t)tok * 1024 + h * 128, 1024);
    }
    __syncthreads();
}

__global__ void __launch_bounds__(NWAVES * 64, 2) mk_fwd(Args args) {
    extern __shared__ __attribute__((aligned(16))) unsigned char lds_raw[];
    Frame F;
    F.lds = (LAS unsigned char*)lds_raw;
    F.tid = threadIdx.x; F.lane = F.tid & 63; F.wave = __builtin_amdgcn_readfirstlane(F.tid >> 6); F.G = gridDim.x;
    F.in = args.in;
    F.out = args.out; F.ws = args.ws; F.ctl = (unsigned*)(args.ws + WS_CTL);
#ifdef PROJ_IN_OUT
    F.proj = (bf16*)args.out;
#else
    F.proj = (bf16*)(args.ws + WS_PROJ);
#endif
    volatile LAS unsigned* MISC = (volatile LAS unsigned*)(F.lds + MISC_OFF);
    if (F.tid < 64) MISC[F.tid] = 0u;
    __syncthreads();
    const int lo = args.ph_lo, hi = args.ph_hi;
    const bool multi = (hi - lo) > 1;
    XcdBarrier bar; bar.bar = F.ctl + CW_BAR; bar.x = 0; bar.st = nullptr;
    if (multi) bar = xcd_barrier_post(F.ctl + CW_BAR, MISC + 8);
#ifndef PH_MASK
#define PH_MASK 0xFFFF
#endif
#define IN(k) (((PH_MASK >> (k)) & 1) && lo <= (k) && (k) < hi)
#define BOTH(k) (IN(k) && IN((k) + 1))
#ifndef REPK
#define REPK -1
#define REPN 1
#endif
#define NREP(k) (((k) == REPK) ? REPN : 1)
#define PHASE(k, ...) if (IN(k)) { for (int rep_ = 0; rep_ < NREP(k); ++rep_) { __VA_ARGS__; if (rep_ + 1 < NREP(k)) xcd_barrier(bar); } if (BOTH(k)) xcd_barrier(bar); }
    PHASE(0, p0_prologue(F))
    PHASE(1, p1_norm1(F))
    PHASE(2, { pg8::DenseOrder S; S.init(F.ws + WS_ACT1, F.ws + WS_WIN, T_TOK, N_PROJ, 1024, F.G, (int)blockIdx.x);
        MkEpiBf16 E{F.proj, N_PROJ};
        pg8::gemm_phase<MkEpiBf16, pg8::DenseOrder, true>(F.lds, 1024, S, E); })
    PHASE(3, { for (int unit = blockIdx.x; unit < 256; unit += F.G) p3_unit<0>(F, unit); })
    PHASE(4, { for (int unit = blockIdx.x; unit < 256; unit += F.G) p4_unit<0>(F, unit, (bf16*)(F.ws + WS_ACT1)); })
    PHASE(5, { pg8::DenseOrder S; S.init(F.ws + WS_ACT1, F.ws + WS_WOUT, T_TOK, 1024, 1024, F.G, (int)blockIdx.x);
        MkEpiMix E{(const float*)(F.ws + WS_MOD), (bf16*)(F.ws + WS_MIXG)};
        pg8::gemm_phase<MkEpiMix, pg8::DenseOrder, true>(F.lds, 1024, S, E); })
    PHASE(6, { if (rep_ > 0) { if (blockIdx.x == 0 && F.tid < 32) F.ctl[CW_CNT + F.tid] = 0u; xcd_barrier(bar); }
        for (int grp = blockIdx.x; grp < 256; grp += F.G) p6_router_group(F, grp); })
    PHASE(7, { moe_table(F);
        LAS int* ts = (LAS int*)(F.lds + MOE_OFF);
        MoeOrder S{(const char*)(F.ws + WS_ACT1), (const char*)(F.ws + WS_WGU), (const int*)(F.ws + WS_LIST), ts, ts + 33, 1024, (size_t)1024 * 1024 * 2, F.G, (int)blockIdx.x, true};
        MkEpiSwiglu E{(bf16*)(F.ws + WS_HID)};
        pg8::gemm_phase<MkEpiSwiglu, MoeOrder, true>(F.lds, 1024, S, E); })
    PHASE(8, { moe_table(F);
        LAS int* ts = (LAS int*)(F.lds + MOE_OFF);
        MoeOrder S{(const char*)(F.ws + WS_HID), (const char*)(F.ws + WS_WD), (const int*)(F.ws + WS_LIST), ts, ts + 33, 512, (size_t)1024 * 512 * 2, F.G, (int)blockIdx.x, false};
        MkEpiSlot E{(bf16*)(F.ws + WS_SLOT), (const int*)(F.ws + WS_LIST), (const float*)(F.ws + WS_ASGG)};
        pg8::gemm_phase<MkEpiSlot, MoeOrder, true>(F.lds, 512, S, E); })
    if (IN(9)) { p9_final(F); }
#ifdef TVAR3
    if (IN(13)) { for (int unit = blockIdx.x; unit < 256; unit += F.G) p3_unit<TVAR3>(F, unit); }
#endif
#ifdef TVAR4
    if (IN(14)) { for (int unit = blockIdx.x; unit < 256; unit += F.G) p4_unit<TVAR4>(F, unit, (bf16*)(F.ws + WS_ACT1)); }
#endif
#undef IN
#undef BOTH
}

__global__ void __launch_bounds__(256) k_glue_y(const float* proj, bf16* y) {
    const int t = blockIdx.x;
    for (int c = threadIdx.x; c < 1024; c += 256) { const float v = proj[(size_t)t * 2056 + c]; y[(size_t)t * 1024 + c] = (bf16)(pg8::cvt_pk_bf16(v, 0.f) & 0xffffu); }
}

__global__ void __launch_bounds__(256) k_glue_proj(const bf16* pb, const float* gif, float* proj) {
    const int t = blockIdx.x;
    for (int c = threadIdx.x; c < 2056; c += 256) {
        float v;
        if (c < 1536) v = bf2f(pb[(size_t)t * 2048 + c]);
        else if (c < 1544) v = gif[(size_t)t * 8 + (c - 1536)];
        else v = bf2f(pb[(size_t)t * 2048 + (c - 8)]);
        proj[(size_t)t * 2056 + c] = v;
    }
}

#ifdef DIAG_P4_TWICE
__global__ void k_diag_cmp(const unsigned* a, const unsigned* b, unsigned* flag) {
    const size_t i = (size_t)blockIdx.x * 256 + threadIdx.x;
    const size_t t = i >> 8, c = i & 255;
    if (a[t * 512 + c] != b[t * 512 + c]) atomicAdd(flag, 1u);
}
__global__ void k_diag_poison(float* out, const unsigned* flag) { if (*flag) out[threadIdx.x] = __builtin_nanf(""); }
#endif

extern "C" void kernel_launch(void* const* d_in, const int* in_sizes, int n_in, void* d_out, int out_size, void* d_ws, size_t ws_size, hipStream_t stream) {
    static int inited = 0;
    if (!inited) { (void)hipFuncSetAttribute((const void*)mk_fwd, hipFuncAttributeMaxDynamicSharedMemorySize, LDS_BYTES); inited = 1; }
    (void)hipMemsetAsync((char*)d_ws + WS_CTL, 0, CTL_ZERO_BYTES, stream);
    Args a{};
    for (int i = 0; i < 27; ++i) a.in[i] = (const float*)d_in[i];
    a.out = (float*)d_out; a.ws = (unsigned char*)d_ws;
    a.ph_lo = 0; a.ph_hi = 10;
    mk_fwd<<<256, 512, LDS_BYTES, stream>>>(a);
}
```
